# Optimizing an MI355X kernel written in HIP

```python
import math
import jax, jax.numpy as jnp
from jax import lax
import numpy as np

D_MODEL = 2048
BATCH = 8
SEQ = 2048
DEPTH = 2
DEC_BATCH = 8
DEC_SEQ = 4096
PAST_LEN = 128

HEAD_DIM = 128
GRID_W = 64
Q_BLOCK = 128
EPS = 1e-6
NEG_INF = -1e30

A_HEADS = D_MODEL // (4 * HEAD_DIM)
B_HEADS = D_MODEL // (2 * HEAD_DIM)
NA_KH_MAX = 8
NA_KW = 16
C_PATTERNS = ((128, 1), (512, 4), (2048, 16))
C_HEADS_PER_GROUP = D_MODEL // (4 * HEAD_DIM)
C_HEADS = len(C_PATTERNS) * C_HEADS_PER_GROUP
D_HEADS = 3 * D_MODEL // (4 * HEAD_DIM)
D_KV_HEADS = D_HEADS // 3
ROPE_THETA = 10000.0
ROPE_ROW_DIMS = HEAD_DIM // 2
ROPE_COL_DIMS = HEAD_DIM - ROPE_ROW_DIMS
FFN_HIDDEN = ((8 * D_MODEL + 3 * 256 - 1) // (3 * 256)) * 256

A_W = A_HEADS * 2 * HEAD_DIM
B_W = B_HEADS * HEAD_DIM
EV_IN = 3 * A_W + 3 * B_W
EV_OUT = A_W + B_W
C_W = C_HEADS * HEAD_DIM
DQ_W = D_HEADS * HEAD_DIM
DKV_W = D_KV_HEADS * HEAD_DIM
OD_IN = 3 * C_W + DQ_W + 2 * DKV_W
OD_OUT = C_HEADS_PER_GROUP * HEAD_DIM + DQ_W
N_EVEN = (DEPTH + 1) // 2
N_ODD = DEPTH // 2

kernel_name = "hybrid_diff_na_dilated_axial_encoder"


def rms_norm(x, g):
    xf = x.astype(jnp.float32)
    y = xf * lax.rsqrt(jnp.mean(xf * xf, axis=-1, keepdims=True) + EPS)
    return (y * g.astype(jnp.float32)).astype(x.dtype)


def alibi_slopes(n):
    return jnp.asarray([2.0 ** (-8.0 * (i + 1) / n) for i in range(n)], dtype=jnp.float32)


def lambda_init_fn(layer_idx):
    return 0.8 - 0.6 * math.exp(-0.3 * layer_idx)


def diff_attention(q, k, v, lam, slopes):
    B, H, S, _, hd = q.shape
    nblk = S // Q_BLOCK
    scale = hd ** -0.5
    kpos = jnp.arange(S)
    qblocks = q.reshape(B, H, nblk, Q_BLOCK, 2, hd).transpose(2, 0, 1, 3, 4, 5)

    def block(args):
        qi, bi = args
        s = jnp.einsum("bhqcd,bhkcd->bhcqk", qi, k, preferred_element_type=jnp.float32) * scale
        qpos = bi * Q_BLOCK + jnp.arange(Q_BLOCK)
        dist = jnp.abs(qpos[:, None] - kpos[None, :]).astype(jnp.float32)
        s = s - (slopes[:, None, None] * dist)[None, :, None]
        p = jax.nn.softmax(s, axis=-1)
        a = p[:, :, 0] - lam * p[:, :, 1]
        return jnp.einsum("bhqk,bhkd->bhqd", a.astype(v.dtype), v)

    o = lax.map(block, (qblocks, jnp.arange(nblk)))
    return o.transpose(1, 2, 0, 3, 4).reshape(B, H, S, 2 * hd)


def neighbourhood_attention(q, k, v, rpb):
    B, H, S, hd = q.shape
    rows = S // GRID_W
    kh = min(NA_KH_MAX, rows)
    scale = hd ** -0.5
    qg = q.reshape(B, H, rows, GRID_W, hd)
    kg = k.reshape(B, H, rows, GRID_W, hd)
    vg = v.reshape(B, H, rows, GRID_W, hd)
    c = jnp.arange(GRID_W)
    c0 = jnp.clip(c - NA_KW // 2, 0, GRID_W - NA_KW)
    col_mask = (c[None, :] >= c0[:, None]) & (c[None, :] < c0[:, None] + NA_KW)
    dc = jnp.clip(c[None, :] - c[:, None], 1 - NA_KW, NA_KW - 1) + NA_KW - 1
    rpb_cols = jnp.take(rpb, dc, axis=2)

    def row_block(r):
        r0 = jnp.clip(r - kh // 2, 0, rows - kh)
        qr = lax.dynamic_index_in_dim(qg, r, axis=2, keepdims=False)
        kr = lax.dynamic_slice_in_dim(kg, r0, kh, axis=2)
        vr = lax.dynamic_slice_in_dim(vg, r0, kh, axis=2)
        s = jnp.einsum("bhqd,bhiwd->bhqiw", qr, kr, preferred_element_type=jnp.float32) * scale
        dr = r0 + jnp.arange(kh) - r + NA_KH_MAX - 1
        bias = jnp.take(rpb_cols, dr, axis=1).transpose(0, 2, 1, 3)
        s = jnp.where(col_mask[:, None, :], s + bias[None], NEG_INF)
        p = jax.nn.softmax(s.reshape(B, H, GRID_W, kh * GRID_W), axis=-1).reshape(s.shape)
        return jnp.einsum("bhqiw,bhiwd->bhqd", p.astype(v.dtype), vr)

    o = lax.map(row_block, jnp.arange(rows))
    return o.transpose(1, 2, 0, 3, 4).reshape(B, H, S, hd)


def dilated_group(q, k, v, dil, radius, slopes):
    B, H, S, hd = q.shape
    L = S // dil
    scale = hd ** -0.5

    def split(a):
        return a.reshape(B, H, L, dil, hd).transpose(0, 1, 3, 2, 4)

    qs, ks, vs = split(q), split(k), split(v)
    qb = min(Q_BLOCK, L)
    nblk = -(-L // qb)
    Lp = nblk * qb
    qs = jnp.pad(qs, ((0, 0), (0, 0), (0, 0), (0, Lp - L), (0, 0)))
    kpad = ((0, 0), (0, 0), (0, 0), (radius, radius + Lp - L), (0, 0))
    kp, vp = jnp.pad(ks, kpad), jnp.pad(vs, kpad)
    band = jnp.arange(nblk)[:, None] * qb + jnp.arange(qb + 2 * radius)[None, :]
    kb = jnp.take(kp, band, axis=3)
    vb = jnp.take(vp, band, axis=3)
    qbk = qs.reshape(B, H, dil, nblk, qb, hd)
    s = jnp.einsum("bhrnqd,bhrnkd->bhrnqk", qbk, kb, preferred_element_type=jnp.float32) * scale
    qm = jnp.arange(nblk)[:, None] * qb + jnp.arange(qb)[None, :]
    km = band - radius
    rel = km[:, None, :] - qm[:, :, None]
    valid = (jnp.abs(rel) <= radius) & (km[:, None, :] >= 0) & (km[:, None, :] < L)
    dist = (dil * jnp.abs(rel)).astype(jnp.float32)
    bias = -slopes[:, None, None, None] * dist
    s = jnp.where(valid, s + bias[None, :, None], NEG_INF)
    lse = jax.nn.logsumexp(s, axis=-1)
    p = jnp.exp(s - lse[..., None])
    o = jnp.einsum("bhrnqk,bhrnkd->bhrnqd", p.astype(v.dtype), vb)
    o = o.reshape(B, H, dil, Lp, hd)[:, :, :, :L].transpose(0, 1, 3, 2, 4).reshape(B, H, S, hd)
    lse = lse.reshape(B, H, dil, Lp)[:, :, :, :L].transpose(0, 1, 3, 2).reshape(B, H, S)
    return o, lse


def axial_rope(S):
    t = jnp.arange(S)
    row = (t // GRID_W).astype(jnp.float32)
    col = (t % GRID_W).astype(jnp.float32)
    f_row = ROPE_THETA ** (-jnp.arange(0, ROPE_ROW_DIMS, 2, dtype=jnp.float32) / ROPE_ROW_DIMS)
    f_col = ROPE_THETA ** (-jnp.arange(0, ROPE_COL_DIMS, 2, dtype=jnp.float32) / ROPE_COL_DIMS)
    ang = jnp.concatenate([row[:, None] * f_row[None, :], col[:, None] * f_col[None, :]], axis=-1)
    return jnp.cos(ang), jnp.sin(ang)


def apply_rope(x, cos, sin):
    xf = x.astype(jnp.float32).reshape(x.shape[:-1] + (x.shape[-1] // 2, 2))
    x0, x1 = xf[..., 0], xf[..., 1]
    y = jnp.stack([x0 * cos - x1 * sin, x0 * sin + x1 * cos], axis=-1)
    return y.reshape(x.shape).astype(x.dtype)


def gqa_attention(q, k, v):
    B, Hq, S, hd = q.shape
    Hkv = k.shape[1]
    G = Hq // Hkv
    nblk = S // Q_BLOCK
    scale = hd ** -0.5
    qblocks = q.reshape(B, Hkv, G, nblk, Q_BLOCK, hd).transpose(3, 0, 1, 2, 4, 5)

    def block(qi):
        s = jnp.einsum("bkgqd,bksd->bkgqs", qi, k, preferred_element_type=jnp.float32) * scale
        p = jax.nn.softmax(s, axis=-1)
        return jnp.einsum("bkgqs,bksd->bkgqd", p.astype(v.dtype), v)

    o = lax.map(block, qblocks)
    return o.transpose(1, 2, 3, 0, 4, 5).reshape(B, Hq, S, hd)


def heads(a, n):
    B, S, _ = a.shape
    return a.reshape(B, S, n, -1).transpose(0, 2, 1, 3)


def even_mixer(h, w_in, lam_vec, subln_g, rpb, w_out, lambda_init):
    B, S, _ = h.shape
    proj = h @ w_in
    cuts = np.cumsum([A_W, A_W, A_W, B_W, B_W]).tolist()
    qa, ka, va, qn, kn, vn = jnp.split(proj, cuts, axis=-1)
    qa = qa.reshape(B, S, A_HEADS, 2, HEAD_DIM).transpose(0, 2, 1, 3, 4)
    ka = ka.reshape(B, S, A_HEADS, 2, HEAD_DIM).transpose(0, 2, 1, 3, 4)
    va = heads(va, A_HEADS)
    lv = lam_vec.astype(jnp.float32)
    lam = jnp.exp(jnp.sum(lv[0] * lv[1])) - jnp.exp(jnp.sum(lv[2] * lv[3])) + lambda_init
    oa = diff_attention(qa, ka, va, lam, alibi_slopes(A_HEADS))
    oa = rms_norm(oa, subln_g) * (1.0 - lambda_init)
    oa = oa.transpose(0, 2, 1, 3).reshape(B, S, A_W)
    ob = neighbourhood_attention(heads(qn, B_HEADS), heads(kn, B_HEADS), heads(vn, B_HEADS), rpb)
    ob = ob.transpose(0, 2, 1, 3).reshape(B, S, B_W)
    return jnp.concatenate([oa, ob], axis=-1) @ w_out


def odd_mixer(h, w_in, qk_norm_g, w_out):
    B, S, _ = h.shape
    proj = h @ w_in
    cuts = np.cumsum([C_W, C_W, C_W, DQ_W, DKV_W]).tolist()
    qc, kc, vc, qd, kd, vd = jnp.split(proj, cuts, axis=-1)
    ng = len(C_PATTERNS)
    qc = qc.reshape(B, S, ng, C_HEADS_PER_GROUP, HEAD_DIM)
    kc = kc.reshape(B, S, ng, C_HEADS_PER_GROUP, HEAD_DIM)
    vc = vc.reshape(B, S, ng, C_HEADS_PER_GROUP, HEAD_DIM)
    slopes = alibi_slopes(C_HEADS).reshape(ng, C_HEADS_PER_GROUP)
    outs, lses = [], []
    for g, (win, dil) in enumerate(C_PATTERNS):
        o, l = dilated_group(qc[:, :, g].transpose(0, 2, 1, 3), kc[:, :, g].transpose(0, 2, 1, 3),
                             vc[:, :, g].transpose(0, 2, 1, 3), dil, win // (2 * dil), slopes[g])
        outs.append(o)
        lses.append(l)
    alpha = jax.nn.softmax(jnp.stack(lses, axis=0), axis=0)
    oc = jnp.sum(alpha[..., None] * jnp.stack(outs, axis=0).astype(jnp.float32), axis=0).astype(h.dtype)
    oc = oc.transpose(0, 2, 1, 3).reshape(B, S, C_HEADS_PER_GROUP * HEAD_DIM)
    cos, sin = axial_rope(S)
    qd = apply_rope(rms_norm(heads(qd, D_HEADS), qk_norm_g[0]), cos, sin)
    kd = apply_rope(rms_norm(heads(kd, D_KV_HEADS), qk_norm_g[1]), cos, sin)
    od = gqa_attention(qd, kd, heads(vd, D_KV_HEADS))
    od = od.transpose(0, 2, 1, 3).reshape(B, S, DQ_W)
    return jnp.concatenate([oc, od], axis=-1) @ w_out


def swiglu(h, w_gate, w_up, w_down):
    return (jax.nn.silu(h @ w_gate) * (h @ w_up)) @ w_down


def trunk(x, attn_norm_g, ev_w_in, ev_lambda, ev_subln_g, ev_rpb, ev_w_out,
          od_w_in, od_qk_norm_g, od_w_out, ffn_norm_g, ffn_w_gate, ffn_w_up, ffn_w_down,
          final_norm_g):
    h = x
    for i in range(DEPTH):
        hn = rms_norm(h, attn_norm_g[i])
        j = i // 2
        if i % 2 == 0:
            h = h + even_mixer(hn, ev_w_in[j], ev_lambda[j], ev_subln_g[j], ev_rpb[j],
                               ev_w_out[j], lambda_init_fn(i))
        else:
            h = h + odd_mixer(hn, od_w_in[j], od_qk_norm_g[j], od_w_out[j])
        h = h + swiglu(rms_norm(h, ffn_norm_g[i]), ffn_w_gate[i], ffn_w_up[i], ffn_w_down[i])
    return rms_norm(h, final_norm_g)


def setup_inputs(seed: int = 0) -> dict:
    key = jax.random.key(seed)
    ks = jax.random.split(key, 17)
    f32 = jnp.float32

    def nrm(k, shape, scale):
        return jax.random.normal(k, shape, f32) * scale

    D = D_MODEL
    return {
        "x_prompt": nrm(ks[0], (BATCH, SEQ, D), 1.0),
        "x_sample": nrm(ks[1], (DEC_BATCH, DEC_SEQ, D), 1.0),
        "attn_norm_g": 1.0 + nrm(ks[2], (DEPTH, D), 0.02),
        "ev_w_in": nrm(ks[3], (N_EVEN, D, EV_IN), D ** -0.5),
        "ev_lambda": nrm(ks[4], (N_EVEN, 4, HEAD_DIM), 0.1),
        "ev_subln_g": 1.0 + nrm(ks[5], (N_EVEN, 2 * HEAD_DIM), 0.02),
        "ev_rpb": nrm(ks[6], (N_EVEN, B_HEADS, 2 * NA_KH_MAX - 1, 2 * NA_KW - 1), 0.1),
        "ev_w_out": nrm(ks[7], (N_EVEN, EV_OUT, D), EV_OUT ** -0.5),
        "od_w_in": nrm(ks[8], (N_ODD, D, OD_IN), D ** -0.5),
        "od_qk_norm_g": 1.0 + nrm(ks[9], (N_ODD, 2, HEAD_DIM), 0.02),
        "od_w_out": nrm(ks[10], (N_ODD, OD_OUT, D), OD_OUT ** -0.5),
        "ffn_norm_g": 1.0 + nrm(ks[11], (DEPTH, D), 0.02),
        "ffn_w_gate": nrm(ks[12], (DEPTH, D, FFN_HIDDEN), D ** -0.5),
        "ffn_w_up": nrm(ks[13], (DEPTH, D, FFN_HIDDEN), D ** -0.5),
        "ffn_w_down": nrm(ks[14], (DEPTH, FFN_HIDDEN, D), FFN_HIDDEN ** -0.5),
        "final_norm_g": 1.0 + nrm(ks[15], (D,), 0.02),
    }


def reference(x_prompt, x_sample, attn_norm_g, ev_w_in, ev_lambda, ev_subln_g, ev_rpb, ev_w_out,
              od_w_in, od_qk_norm_g, od_w_out, ffn_norm_g, ffn_w_gate, ffn_w_up, ffn_w_down,
              final_norm_g):
    y_prompt = trunk(x_prompt, attn_norm_g, ev_w_in, ev_lambda, ev_subln_g, ev_rpb, ev_w_out,
                     od_w_in, od_qk_norm_g, od_w_out, ffn_norm_g, ffn_w_gate, ffn_w_up, ffn_w_down,
                     final_norm_g)
    y_sample = trunk(x_sample, attn_norm_g, ev_w_in, ev_lambda, ev_subln_g, ev_rpb, ev_w_out,
                     od_w_in, od_qk_norm_g, od_w_out, ffn_norm_g, ffn_w_gate, ffn_w_up, ffn_w_down,
                     final_norm_g)
    return (y_prompt, y_sample)
```

```cpp
#include <hip/hip_runtime.h>
#include <hip/hip_cooperative_groups.h>
#include <cstdio>
#include <cstdint>
namespace cg = cooperative_groups;

typedef unsigned short bf16_t;
typedef short bf16x8 __attribute__((ext_vector_type(8)));
typedef short s16x4 __attribute__((ext_vector_type(4)));
typedef float f32x4 __attribute__((ext_vector_type(4)));
typedef float f32x16 __attribute__((ext_vector_type(16)));
typedef unsigned u32x4 __attribute__((ext_vector_type(4)));
typedef unsigned u32x2 __attribute__((ext_vector_type(2)));

constexpr int DM = 2048, FF = 5632, TCMAX = 32768, NCHUNK = 2;
constexpr int EVN = 6144, ODN = 7168;
constexpr float EPS = 1e-6f;
constexpr int NTHREADS = 512;

constexpr size_t SZ_WINE = (size_t)EVN * DM * 2, SZ_WOUT = (size_t)DM * DM * 2, SZ_WINO = (size_t)ODN * DM * 2;
constexpr size_t SZ_WGU = (size_t)2 * FF * DM * 2, SZ_WD = (size_t)DM * FF * 2;
constexpr size_t OFF_WINE = 0;
constexpr size_t OFF_WOUTE = OFF_WINE + SZ_WINE;
constexpr size_t OFF_WINO = OFF_WOUTE + SZ_WOUT;
constexpr size_t OFF_WOUTO = OFF_WINO + SZ_WINO;
constexpr size_t OFF_WGU = OFF_WOUTO + SZ_WOUT;
constexpr size_t OFF_WD = OFF_WGU + 2 * SZ_WGU;
constexpr size_t OFF_XN = OFF_WD + 2 * SZ_WD;
constexpr size_t OFF_PROJ = OFF_XN + (size_t)TCMAX * DM * 2;
constexpr size_t OFF_AO = OFF_PROJ + (size_t)TCMAX * ODN * 2;
constexpr size_t OFF_TMP = OFF_AO + (size_t)TCMAX * DM * 2;
constexpr size_t OFF_LSE = OFF_TMP + (size_t)TCMAX * 1024 * 2;
constexpr size_t OFF_BAR = OFF_LSE + (size_t)3 * TCMAX * 4 * 4;
constexpr size_t BAR_BYTES = 3456 * 4;
constexpr size_t OFF_SSQ = OFF_BAR + BAR_BYTES;
constexpr size_t SSQ_BYTES = (size_t)NCHUNK * 5 * TCMAX * 4;
constexpr size_t OFF_WQ = OFF_SSQ + SSQ_BYTES;
constexpr size_t WQ_BYTES = (size_t)NCHUNK * 8 * 256;
constexpr size_t ZERO_BYTES = BAR_BYTES + SSQ_BYTES + WQ_BYTES;
constexpr size_t WS_END = OFF_WQ + WQ_BYTES;

struct Params {
  const float* x_prompt; const float* x_sample; const float* attn_norm_g; const float* ev_w_in; const float* ev_lambda;
  const float* ev_subln_g; const float* ev_rpb; const float* ev_w_out; const float* od_w_in; const float* od_qk_norm_g;
  const float* od_w_out; const float* ffn_norm_g; const float* ffn_w_gate; const float* ffn_w_up; const float* ffn_w_down;
  const float* final_norm_g; float* out; char* ws;
};

__device__ __forceinline__ unsigned cvtpk(float lo, float hi) {
  unsigned r; asm volatile("v_cvt_pk_bf16_f32 %0, %1, %2" : "=v"(r) : "v"(lo), "v"(hi)); return r;
}
__device__ __forceinline__ float bflo(unsigned w) { return __uint_as_float(w << 16); }
__device__ __forceinline__ float bfhi(unsigned w) { return __uint_as_float(w & 0xffff0000u); }
__device__ __forceinline__ float wave_sum(float v) {
#pragma unroll
  for (int o = 32; o > 0; o >>= 1) v += __shfl_xor(v, o, 64);
  return v;
}
__device__ __forceinline__ int otid() { int t = threadIdx.x; asm volatile("" : "+v"(t)); return t; }
__device__ __forceinline__ int obid() { int b = blockIdx.x; asm volatile("" : "+s"(b)); return b; }
__device__ __forceinline__ int perm32(int rho) { const int n = rho >> 4, i = rho & 15; return 8 * (i >> 2) + 4 * n + (i & 3); }

__device__ __forceinline__ void convert_tile(const float* __restrict__ src, int N, int K, bf16_t* __restrict__ dst, int tk, int tn4, int mode, float* tile, const float* __restrict__ gk) {
  const int tid = otid();
#pragma unroll
  for (int i = 0; i < 8; ++i) {
    const int idx = tid + i * 512; const int r = idx >> 6, c4 = (idx & 63) * 4;
    f32x4 v = *(const f32x4*)(src + (size_t)(tk * 64 + r) * N + tn4 * 256 + c4);
    if (gk != nullptr) v *= gk[tk * 64 + r];
    float* tp = tile + (c4 >> 6) * (64 * 65) + r * 65 + (c4 & 63);
    tp[0] = v[0]; tp[1] = v[1]; tp[2] = v[2]; tp[3] = v[3];
  }
  __syncthreads();
#pragma unroll
  for (int i = 0; i < 4; ++i) {
    const int ch = tid + i * 512; const int d = ch >> 3, k8 = (ch & 7) * 8; const int sub = d >> 6, dd = d & 63;
    const int nsrc = (dd & 32) + perm32(dd & 31);
    const float* tp = tile + sub * (64 * 65) + k8 * 65 + nsrc;
    const u32x4 w = {cvtpk(tp[0], tp[65]), cvtpk(tp[2 * 65], tp[3 * 65]), cvtpk(tp[4 * 65], tp[5 * 65]), cvtpk(tp[6 * 65], tp[7 * 65])};
    const int tn = tn4 * 4 + sub;
    int row0 = tn * 64;
    if (mode) row0 = (tn >> 1) * 256 + (tn & 1) * 64 + (mode == 2 ? 128 : 0);
    *(u32x4*)(dst + (size_t)(row0 + dd) * K + tk * 64 + k8) = w;
  }
  __syncthreads();
}

__device__ __forceinline__ void convert_weights(const Params& p, float* tile) {
  constexpr int T_INE = 32 * (EVN / 256), T_OUT = 32 * (DM / 256), T_INO = 32 * (ODN / 256), T_GU = 32 * (FF / 256), T_D = (FF / 64) * (DM / 256);
  constexpr int TOTAL = T_INE + T_OUT + T_INO + T_OUT + 4 * T_GU + 2 * T_D;
  char* ws = p.ws;
  for (int L = obid(); L < TOTAL; L += gridDim.x) {
    int t = L; const float* src; bf16_t* dst; int K, N, mode = 0; const float* gk = nullptr;
    if (t < T_INE) { src = p.ev_w_in; dst = (bf16_t*)(ws + OFF_WINE); K = DM; N = EVN; gk = p.attn_norm_g; }
    else if ((t -= T_INE) < T_OUT) { src = p.ev_w_out; dst = (bf16_t*)(ws + OFF_WOUTE); K = DM; N = DM; }
    else if ((t -= T_OUT) < T_INO) { src = p.od_w_in; dst = (bf16_t*)(ws + OFF_WINO); K = DM; N = ODN; gk = p.attn_norm_g + DM; }
    else if ((t -= T_INO) < T_OUT) { src = p.od_w_out; dst = (bf16_t*)(ws + OFF_WOUTO); K = DM; N = DM; }
    else if ((t -= T_OUT) < 2 * T_GU) { const int l = t / T_GU; t -= l * T_GU; src = p.ffn_w_gate + (size_t)l * DM * FF; dst = (bf16_t*)(ws + OFF_WGU + l * SZ_WGU); K = DM; N = FF; mode = 1; gk = p.ffn_norm_g + l * DM; }
    else if ((t -= 2 * T_GU) < 2 * T_GU) { const int l = t / T_GU; t -= l * T_GU; src = p.ffn_w_up + (size_t)l * DM * FF; dst = (bf16_t*)(ws + OFF_WGU + l * SZ_WGU); K = DM; N = FF; mode = 2; gk = p.ffn_norm_g + l * DM; }
    else { t -= 2 * T_GU; const int l = t / T_D; t -= l * T_D; src = p.ffn_w_down + (size_t)l * FF * DM; dst = (bf16_t*)(ws + OFF_WD + l * SZ_WD); K = FF; N = DM; }
    const int nnt = N / 256; const int tn4 = t % nnt, tk = t / nnt;
    convert_tile(src, N, K, dst, tk, tn4, mode, tile, gk);
  }
}

template <bool OUT_F32>
__device__ __forceinline__ void rmsnorm_rows(const float* __restrict__ in, const float* __restrict__ g, bf16_t* __restrict__ outb, float* __restrict__ outf, int nrows) {
  const int tid_ = otid(); const int lane = tid_ & 63; const int gw = obid() * 8 + (tid_ >> 6), nw = gridDim.x * 8;
  for (int row = gw; row < nrows; row += nw) {
    const float* rp = in + (size_t)row * DM; f32x4 v[8]; float ss = 0.f;
#pragma unroll
    for (int i = 0; i < 8; ++i) { v[i] = *(const f32x4*)(rp + (i * 64 + lane) * 4); ss += v[i][0] * v[i][0] + v[i][1] * v[i][1] + v[i][2] * v[i][2] + v[i][3] * v[i][3]; }
    ss = wave_sum(ss); const float rs = rsqrtf(ss * (1.f / DM) + EPS);
#pragma unroll
    for (int i = 0; i < 8; ++i) {
      const f32x4 g4 = *(const f32x4*)(g + (i * 64 + lane) * 4);
      const float y0 = v[i][0] * rs * g4[0], y1 = v[i][1] * rs * g4[1], y2 = v[i][2] * rs * g4[2], y3 = v[i][3] * rs * g4[3];
      if constexpr (OUT_F32) { const f32x4 y = {y0, y1, y2, y3}; *(f32x4*)(outf + (size_t)row * DM + (i * 64 + lane) * 4) = y; }
      else { const u32x2 w = {cvtpk(y0, y1), cvtpk(y2, y3)}; *(u32x2*)(outb + (size_t)row * DM + (i * 64 + lane) * 4) = w; }
    }
  }
}

__device__ __forceinline__ void final_norm_rows(const bf16_t* __restrict__ in, const float* __restrict__ g, float* __restrict__ outf, int nrows) {
  const int tid_ = otid(); const int lane = tid_ & 63; const int gw = obid() * 8 + (tid_ >> 6), nw = gridDim.x * 8;
  for (int row = gw; row < nrows; row += nw) {
    const bf16_t* rp = in + (size_t)row * DM; u32x4 v[4]; float ss = 0.f;
#pragma unroll
    for (int i = 0; i < 4; ++i) { v[i] = *(const u32x4*)(rp + (i * 64 + lane) * 8);
#pragma unroll
      for (int k = 0; k < 4; ++k) { const float a = bflo(v[i][k]), b = bfhi(v[i][k]); ss += a * a + b * b; } }
    ss = wave_sum(ss); const float rs = rsqrtf(ss * (1.f / DM) + EPS);
#pragma unroll
    for (int i = 0; i < 4; ++i) {
      const f32x4 g0 = *(const f32x4*)(g + (i * 64 + lane) * 8), g1 = *(const f32x4*)(g + (i * 64 + lane) * 8 + 4);
      const f32x4 y0 = {bflo(v[i][0]) * rs * g0[0], bfhi(v[i][0]) * rs * g0[1], bflo(v[i][1]) * rs * g0[2], bfhi(v[i][1]) * rs * g0[3]};
      const f32x4 y1 = {bflo(v[i][2]) * rs * g1[0], bfhi(v[i][2]) * rs * g1[1], bflo(v[i][3]) * rs * g1[2], bfhi(v[i][3]) * rs * g1[3]};
      *(f32x4*)(outf + (size_t)row * DM + (i * 64 + lane) * 8) = y0; *(f32x4*)(outf + (size_t)row * DM + (i * 64 + lane) * 8 + 4) = y1;
    }
  }
}

__device__ __forceinline__ void cast_rows(const float* __restrict__ in, bf16_t* __restrict__ outb, float* __restrict__ ssq, int nrows) {
  const int tid_ = otid(); const int lane = tid_ & 63; const int gw = obid() * 8 + (tid_ >> 6), nw = gridDim.x * 8;
  for (int row = gw; row < nrows; row += nw) {
    const float* rp = in + (size_t)row * DM; float ss = 0.f;
#pragma unroll
    for (int i = 0; i < 8; ++i) {
      const f32x4 v = *(const f32x4*)(rp + (i * 64 + lane) * 4); ss += v[0] * v[0] + v[1] * v[1] + v[2] * v[2] + v[3] * v[3];
      const u32x2 w = {cvtpk(v[0], v[1]), cvtpk(v[2], v[3])}; *(u32x2*)(outb + (size_t)row * DM + (i * 64 + lane) * 4) = w;
    }
    ss = wave_sum(ss);
    if (lane == 0) ssq[row] = ss;
  }
}

constexpr int BM = 256, BK = 64, HALF = 128, HT = HALF * BK;
constexpr int GEMM_LDS = 8 * HT * 2;
__device__ __forceinline__ int lds_byte(int r, int c) {
  const int st = (r >> 4) * 2 + (c >> 5), rr = r & 15, cc = c & 31, ob = rr * 64 + cc * 2;
  return st * 1024 + (ob ^ (((ob >> 9) & 1) << 5));
}
__device__ __forceinline__ void stage_rc(int b, int& R, int& C) {
  const int st = b / 1024, sb = b % 1024, swz = sb ^ (((sb >> 9) & 1) << 5);
  R = (st >> 1) * 16 + swz / 64; C = (st & 1) * 32 + (swz % 64) / 2;
}
struct EpiArgs { bf16_t* outb; int ldc; const bf16_t* res; float* outf; const float* ssq_in; float* ssq_out; };
#define LAS __attribute__((address_space(3)))

template <int EPI>
__device__ __forceinline__ void gemm_epi(const f32x4 (&acc)[2][2][4][2], const float (&sq)[2][4], const int pm, const int pn, const int wr, const int wc, const int fr, const int fq, const EpiArgs e) {
  const int row0 = pm * BM + wr * 64 + fr, colt = wc * 32 + 8 * fq, bcol = pn * BM;
  if constexpr (EPI == 1) {
    u32x4 rv[2][4][2];
#pragma unroll
    for (int ai = 0; ai < 2; ++ai)
#pragma unroll
      for (int m = 0; m < 4; ++m)
#pragma unroll
        for (int bj = 0; bj < 2; ++bj) rv[ai][m][bj] = *(const u32x4*)(e.res + (size_t)(row0 + ai * HALF + m * 16) * DM + bcol + bj * HALF + colt);
#pragma unroll
    for (int ai = 0; ai < 2; ++ai)
#pragma unroll
      for (int m = 0; m < 4; ++m) {
        const size_t row = (size_t)(row0 + ai * HALF + m * 16);
        float ssr = 0.f;
#pragma unroll
        for (int bj = 0; bj < 2; ++bj) {
          const size_t off = row * DM + bcol + bj * HALF + colt;
          const u32x4 r = rv[ai][m][bj];
          const f32x4 r0 = {bflo(r[0]), bfhi(r[0]), bflo(r[1]), bfhi(r[1])}, r1 = {bflo(r[2]), bfhi(r[2]), bflo(r[3]), bfhi(r[3])};
          const f32x4 o0 = r0 + acc[ai][bj][m][0], o1 = r1 + acc[ai][bj][m][1];
          const u32x4 w = {cvtpk(o0[0], o0[1]), cvtpk(o0[2], o0[3]), cvtpk(o1[0], o1[1]), cvtpk(o1[2], o1[3])};
          *(u32x4*)(e.outb + off) = w;
          ssr += o0[0] * o0[0] + o0[1] * o0[1] + o0[2] * o0[2] + o0[3] * o0[3] + o1[0] * o1[0] + o1[1] * o1[1] + o1[2] * o1[2] + o1[3] * o1[3];
        }
        ssr += __shfl_xor(ssr, 16, 64); ssr += __shfl_xor(ssr, 32, 64);
        if (fq == 0) (void)__hip_atomic_fetch_add(e.ssq_out + row, ssr, __ATOMIC_RELAXED, __HIP_MEMORY_SCOPE_AGENT);
      }
    return;
  }
#pragma unroll
  for (int ai = 0; ai < 2; ++ai)
#pragma unroll
    for (int m = 0; m < 4; ++m) {
      const size_t row = (size_t)(row0 + ai * HALF + m * 16);
      const float var = sq[ai][m] * (1.f / DM) + EPS;
      const float rstd = rsqrtf(var);
      if constexpr (EPI == 0) {
#pragma unroll
        for (int bj = 0; bj < 2; ++bj) {
          const f32x4 a0 = acc[ai][bj][m][0] * rstd, a1 = acc[ai][bj][m][1] * rstd;
          const u32x4 w = {cvtpk(a0[0], a0[1]), cvtpk(a0[2], a0[3]), cvtpk(a1[0], a1[1]), cvtpk(a1[2], a1[3])};
          *(u32x4*)(e.outb + row * e.ldc + bcol + bj * HALF + colt) = w;
        }
      } else {
        float hv[8];
        const float nk = -rstd * 1.4426950408889634f;
#pragma unroll
        for (int n = 0; n < 2; ++n)
#pragma unroll
          for (int j = 0; j < 4; ++j) {
            const float ag = acc[ai][0][m][n][j], au = acc[ai][1][m][n][j];
            const float ex = __builtin_amdgcn_exp2f(ag * nk);
            hv[n * 4 + j] = (ag * au) * __builtin_amdgcn_rcpf(fmaf(ex, var, var));
          }
        const u32x4 w = {cvtpk(hv[0], hv[1]), cvtpk(hv[2], hv[3]), cvtpk(hv[4], hv[5]), cvtpk(hv[6], hv[7])};
        *(u32x4*)(e.outb + row * FF + pn * HALF + colt) = w;
      }
    }
}

__device__ __forceinline__ bool gemm_next(int i, int nM, int nN, int& pm, int& pn) {
  const int nwg = nM * nN; const int L = i * (int)gridDim.x + obid(); if (L >= nwg) return false;
  int wgid = L;
  { const int q = nwg / 8, r = nwg % 8, xcd = wgid % 8, off = wgid / 8; wgid = (xcd < r ? xcd * (q + 1) : r * (q + 1) + (xcd - r) * q) + off; }
  const int nig = 8 * nN, gid = wgid / nig, fm = gid * 8, gsz = min(nM - fm, 8);
  pm = fm + ((wgid % nig) % gsz); pn = (wgid % nig) / gsz; return true;
}

template <int EPI>
__device__ __forceinline__ void gemm_phase(const bf16_t* __restrict__ Ag, const bf16_t* __restrict__ Btg, const int M, const int N, const int K, LAS unsigned char* lds, const EpiArgs e) {
  const int tid = otid(), wid = __builtin_amdgcn_readfirstlane(tid >> 6), lane = tid & 63, wr = wid >> 2, wc = wid & 3, fr = lane & 15, fq = lane >> 4;
  const int nt = K / BK, nM = M / BM, nN = N / BM;
  constexpr int HTB = HALF * BK * 2;
  unsigned voff[2];
#pragma unroll
  for (int i = 0; i < 2; ++i) { int R, C; stage_rc(tid * 16 + i * 8192, R, C); voff[i] = (unsigned)(R * K + C) * 2u; }
  const size_t kstep = (size_t)(BK * 2);
  const size_t hstep = (size_t)HALF * K * 2;
  const size_t tstep = 2 * hstep;
  const unsigned ldsw = (unsigned)wid * 1024u;
  const int aoff = lds_byte(wr * 64 + fr, fq * 8), boff = lds_byte(wc * 32 + fr, fq * 8);
#define PG8_SA(b, h) (((b) * 2 + (h)) * HTB)
#define PG8_SB(b, h) ((4 + (b) * 2 + (h)) * HTB)
#define PG8_STAGE(bufoff, gbase) do { _Pragma("unroll") for (int _i = 0; _i < 2; ++_i) \
    __builtin_amdgcn_global_load_lds((const unsigned*)((const char*)(gbase) + voff[_i]), (LAS unsigned*)(lds + (bufoff) + ldsw + _i * 8192), 16, 0, 0); } while (0)
#define PG8_LDA(dst, b, h) do { _Pragma("unroll") for (int m = 0; m < 4; ++m) _Pragma("unroll") for (int k = 0; k < 2; ++k) dst[m][k] = *(const LAS bf16x8*)(lds + PG8_SA(b, h) + aoff + m * 2048 + k * 1024); } while (0)
#define PG8_LDB(dst, b, h) do { _Pragma("unroll") for (int n = 0; n < 2; ++n) _Pragma("unroll") for (int k = 0; k < 2; ++k) dst[n][k] = *(const LAS bf16x8*)(lds + PG8_SB(b, h) + boff + n * 2048 + k * 1024); } while (0)
#define PG8_MMA(ai, bj, At_, Bt_) do { __builtin_amdgcn_s_setprio(1); _Pragma("unroll") for (int m = 0; m < 4; ++m) _Pragma("unroll") for (int n = 0; n < 2; ++n) _Pragma("unroll") for (int k = 0; k < 2; ++k) \
    acc[ai][bj][m][n] = __builtin_amdgcn_mfma_f32_16x16x32_bf16(Bt_[n][k], At_[m][k], acc[ai][bj][m][n], 0, 0, 0); __builtin_amdgcn_s_setprio(0); } while (0)
#define PG8_WAIT_V(n) asm volatile("s_waitcnt vmcnt(" #n ")" ::: "memory")
#define PG8_WAIT_L(n) asm volatile("s_waitcnt lgkmcnt(" #n ")" ::: "memory")
#define PG8_BAR __builtin_amdgcn_s_barrier()
#define PG8_SCHED __builtin_amdgcn_sched_barrier(0)
  int cpm, cpn, npm = 0, npn = 0, ui = 0;
  if (!gemm_next(0, nM, nN, cpm, cpn)) return;
  f32x4 acc[2][2][4][2];
#pragma unroll
  for (int a = 0; a < 2; ++a)
#pragma unroll
    for (int b = 0; b < 2; ++b)
#pragma unroll
      for (int m = 0; m < 4; ++m)
#pragma unroll
        for (int n = 0; n < 2; ++n) acc[a][b][m][n] = (f32x4){0.f, 0.f, 0.f, 0.f};
  bf16x8 At[4][2], B0[2][2], B1[2][2];
  float sq[2][4] = {};
  const char* cA = (const char*)Ag + (size_t)cpm * tstep; const char* cB = (const char*)Btg + (size_t)cpn * tstep;
  PG8_STAGE(PG8_SB(0, 0), cB); PG8_STAGE(PG8_SB(0, 1), cB + hstep); PG8_STAGE(PG8_SA(0, 0), cA); PG8_STAGE(PG8_SA(0, 1), cA + hstep);
  if (wr == 1) PG8_BAR;
  PG8_WAIT_V(2); PG8_BAR;
  PG8_STAGE(PG8_SB(1, 0), cB + kstep); PG8_STAGE(PG8_SA(1, 0), cA + kstep); PG8_STAGE(PG8_SB(1, 1), cB + hstep + kstep);
  PG8_WAIT_V(6); PG8_BAR;
  for (;;) {
    const bool has_next = gemm_next(ui + 1, nM, nN, npm, npn);
    const char* nA = has_next ? (const char*)Ag + (size_t)npm * tstep : cA; const char* nB = has_next ? (const char*)Btg + (size_t)npn * tstep : cB;
    for (int t = 0; t < nt; t += 2) {
      const bool last = (t == nt - 2);
      const char* a1 = cA + (size_t)(t + 1) * kstep;
      const char* a2 = last ? nA : cA + (size_t)(t + 2) * kstep; const char* b2 = last ? nB : cB + (size_t)(t + 2) * kstep;
      const char* a3 = a2 + kstep; const char* b3 = b2 + kstep;
      if constexpr (EPI != 1) { if (last) {
        const float* sp = e.ssq_in + cpm * BM + wr * 64 + fr;
#pragma unroll
        for (int ai = 0; ai < 2; ++ai)
#pragma unroll
          for (int m = 0; m < 4; ++m) sq[ai][m] = sp[ai * HALF + m * 16];
        PG8_SCHED; } }
      PG8_LDB(B0, 0, 0); PG8_LDB(B1, 0, 1); PG8_SCHED; PG8_LDA(At, 0, 0); PG8_STAGE(PG8_SA(1, 1), a1 + hstep);
      PG8_WAIT_V(8); PG8_WAIT_L(0); PG8_BAR; PG8_MMA(0, 0, At, B0); PG8_MMA(0, 1, At, B1); PG8_BAR; PG8_SCHED;
      PG8_LDA(At, 0, 1); PG8_STAGE(PG8_SB(0, 0), b2); PG8_STAGE(PG8_SB(0, 1), b2 + hstep); PG8_STAGE(PG8_SA(0, 0), a2);
      PG8_WAIT_V(8); PG8_WAIT_L(0); PG8_BAR; PG8_MMA(1, 0, At, B0); PG8_MMA(1, 1, At, B1); PG8_BAR; PG8_SCHED;
      PG8_LDB(B0, 1, 0); PG8_LDB(B1, 1, 1); PG8_SCHED; PG8_LDA(At, 1, 0); PG8_STAGE(PG8_SA(0, 1), a2 + hstep);
      PG8_WAIT_V(8); PG8_WAIT_L(0); PG8_BAR; PG8_MMA(0, 0, At, B0); PG8_MMA(0, 1, At, B1); PG8_BAR; PG8_SCHED;
      PG8_LDA(At, 1, 1); PG8_STAGE(PG8_SB(1, 0), b3); PG8_STAGE(PG8_SB(1, 1), b3 + hstep); PG8_STAGE(PG8_SA(1, 0), a3);
      PG8_WAIT_V(8); PG8_WAIT_L(0); PG8_BAR; PG8_MMA(1, 0, At, B0); PG8_MMA(1, 1, At, B1); PG8_BAR; PG8_SCHED;
    }
    if (wr == 0) PG8_BAR;
    gemm_epi<EPI>(acc, sq, cpm, cpn, wr, wc, fr, fq, e);
    if (!has_next) break;
#pragma unroll
    for (int a = 0; a < 2; ++a)
#pragma unroll
      for (int b = 0; b < 2; ++b)
#pragma unroll
        for (int m = 0; m < 4; ++m)
#pragma unroll
          for (int n = 0; n < 2; ++n) acc[a][b][m][n] = (f32x4){0.f, 0.f, 0.f, 0.f};
    cpm = npm; cpn = npn; cA = nA; cB = nB; ++ui;
    if (wr == 1) PG8_BAR;
  }
  PG8_WAIT_V(0);
  PG8_BAR;
#undef PG8_SA
#undef PG8_SB
#undef PG8_STAGE
#undef PG8_LDA
#undef PG8_LDB
#undef PG8_MMA
#undef PG8_WAIT_V
#undef PG8_WAIT_L
#undef PG8_BAR
#undef PG8_SCHED
}

constexpr float SCALE = 0.088388347648318440f;
constexpr float THR = 8.f;
constexpr float M_INIT = -30000.f, MASKV = -1.0e9f;
constexpr int KVBLK = 64;
constexpr size_t SHM_V = KVBLK * 128 * 2, SHM_K = KVBLK * 128 * 2;
constexpr size_t ATT_TBL_OFF = 2 * SHM_V + 2 * SHM_K + 8 * 64 * 4;
#define KSWZ(row, colB) ((row) * 256 + ((colB) ^ (((row) & 7) << 4)))
#define SBAR() __builtin_amdgcn_sched_barrier(0)
__device__ __forceinline__ int crow(int r, int hi) { return (r & 3) + 8 * (r >> 2) + 4 * hi; }

__device__ __forceinline__ void partialSM(f32x16& p0, f32x16& p1, float& m_reg, float& mn, float& alpha) {
  constexpr float C = SCALE * 1.4426950408889634f;
  float pmax = p0[0];
#pragma unroll
  for (int r = 1; r < 16; ++r) pmax = fmaxf(pmax, p0[r]);
#pragma unroll
  for (int r = 0; r < 16; ++r) pmax = fmaxf(pmax, p1[r]);
  { auto rr = __builtin_amdgcn_permlane32_swap(__float_as_uint(pmax), __float_as_uint(pmax), false, false);
    pmax = fmaxf(__uint_as_float(rr[0]), __uint_as_float(rr[1])); }
  if (__builtin_expect(__all(pmax - m_reg <= THR / SCALE), 1)) { mn = m_reg; alpha = 1.f; }
  else { mn = fmaxf(m_reg, pmax); alpha = __builtin_amdgcn_exp2f((m_reg - mn) * C); m_reg = mn; }
  const float mnC = -mn * C;
#pragma unroll
  for (int r = 0; r < 16; ++r) p0[r] = fmaf(p0[r], C, mnC);
#pragma unroll
  for (int r = 0; r < 16; ++r) p1[r] = fmaf(p1[r], C, mnC);
#pragma unroll
  for (int r = 0; r < 16; ++r) p0[r] = __builtin_amdgcn_exp2f(p0[r]);
}
__device__ __forceinline__ void finishSM(f32x16& p0, f32x16& p1, float alpha, float& l_reg, bf16x8& pa0, bf16x8& pa1, bf16x8& pa2, bf16x8& pa3) {
#pragma unroll
  for (int r = 0; r < 16; ++r) p1[r] = __builtin_amdgcn_exp2f(p1[r]);
  float ps = 0;
#pragma unroll
  for (int r = 0; r < 16; ++r) ps += p0[r];
#pragma unroll
  for (int r = 0; r < 16; ++r) ps += p1[r];
  { auto rr = __builtin_amdgcn_permlane32_swap(__float_as_uint(ps), __float_as_uint(ps), false, false);
    ps = __uint_as_float(rr[0]) + __uint_as_float(rr[1]); }
  l_reg = l_reg * alpha + ps;
#define PK4(P, BASE, OUT) do { unsigned a0 = cvtpk(P[BASE + 0], P[BASE + 1]), a1 = cvtpk(P[BASE + 2], P[BASE + 3]);   \
    unsigned b0 = cvtpk(P[BASE + 4], P[BASE + 5]), b1 = cvtpk(P[BASE + 6], P[BASE + 7]);                              \
    auto r0 = __builtin_amdgcn_permlane32_swap(a0, b0, false, false); auto r1 = __builtin_amdgcn_permlane32_swap(a1, b1, false, false); \
    u32x4 w = {r0[0], r1[0], r0[1], r1[1]}; OUT = *reinterpret_cast<bf16x8*>(&w); } while (0)
  PK4(p0, 0, pa0); PK4(p0, 8, pa1); PK4(p1, 0, pa2); PK4(p1, 8, pa3);
#undef PK4
}
__device__ __forceinline__ bool partialSM_z(f32x16& p0, f32x16& p1, float& m_reg, float& mn, float& alpha) {
  constexpr float C = SCALE * 1.4426950408889634f;
  float pmax = p0[0];
#pragma unroll
  for (int r = 1; r < 16; ++r) pmax = fmaxf(pmax, p0[r]);
#pragma unroll
  for (int r = 0; r < 16; ++r) pmax = fmaxf(pmax, p1[r]);
  { auto rr = __builtin_amdgcn_permlane32_swap(__float_as_uint(pmax), __float_as_uint(pmax), false, false);
    pmax = fmaxf(__uint_as_float(rr[0]), __uint_as_float(rr[1])); }
  const bool allz = __all(pmax - m_reg < -140.f / C);
  if (__builtin_expect(__all(pmax - m_reg <= THR / SCALE), 1)) { mn = m_reg; alpha = 1.f; }
  else { mn = fmaxf(m_reg, pmax); alpha = __builtin_amdgcn_exp2f((m_reg - mn) * C); m_reg = mn; }
  const float mnC = -mn * C;
#pragma unroll
  for (int r = 0; r < 16; ++r) p0[r] = fmaf(p0[r], C, mnC);
#pragma unroll
  for (int r = 0; r < 16; ++r) p1[r] = fmaf(p1[r], C, mnC);
#pragma unroll
  for (int r = 0; r < 16; ++r) p0[r] = __builtin_amdgcn_exp2f(p0[r]);
  return allz;
}
__device__ __forceinline__ void partialSM_fix(f32x16& p0, f32x16& p1, const float m_reg) {
  constexpr float C = SCALE * 1.4426950408889634f;
  const float mnC = -m_reg * C;
#pragma unroll
  for (int r = 0; r < 16; ++r) p0[r] = fmaf(p0[r], C, mnC);
#pragma unroll
  for (int r = 0; r < 16; ++r) p1[r] = fmaf(p1[r], C, mnC);
#pragma unroll
  for (int r = 0; r < 16; ++r) p0[r] = __builtin_amdgcn_exp2f(p0[r]);
}
__device__ __forceinline__ void finishSM_fix(f32x16& p0, f32x16& p1, bf16x8& pa0, bf16x8& pa1, bf16x8& pa2, bf16x8& pa3) {
#pragma unroll
  for (int r = 0; r < 16; ++r) p1[r] = __builtin_amdgcn_exp2f(p1[r]);
#define PK4(P, BASE, OUT) do { unsigned a0 = cvtpk(P[BASE + 0], P[BASE + 1]), a1 = cvtpk(P[BASE + 2], P[BASE + 3]);   \
    unsigned b0 = cvtpk(P[BASE + 4], P[BASE + 5]), b1 = cvtpk(P[BASE + 6], P[BASE + 7]);                              \
    auto r0 = __builtin_amdgcn_permlane32_swap(a0, b0, false, false); auto r1 = __builtin_amdgcn_permlane32_swap(a1, b1, false, false); \
    u32x4 w = {r0[0], r1[0], r0[1], r1[1]}; OUT = *reinterpret_cast<bf16x8*>(&w); } while (0)
  PK4(p0, 0, pa0); PK4(p0, 8, pa1); PK4(p1, 0, pa2); PK4(p1, 8, pa3);
#undef PK4
}
__device__ __forceinline__ void qkt(f32x16& p0, f32x16& p1, const bf16_t* Ks, const bf16x8* qr, int r32, int hi) {
  p0 = f32x16{}; p1 = f32x16{};
#pragma unroll
  for (int d0 = 0; d0 < 8; ++d0) { const int cb = (d0 * 16 + hi * 8) * 2;
    const bf16x8 b0 = *reinterpret_cast<const bf16x8*>((const char*)Ks + KSWZ(r32, cb));
    const bf16x8 b1 = *reinterpret_cast<const bf16x8*>((const char*)Ks + KSWZ(32 + r32, cb));
    p0 = __builtin_amdgcn_mfma_f32_32x32x16_bf16(b0, qr[d0], p0, 0, 0, 0);
    p1 = __builtin_amdgcn_mfma_f32_32x32x16_bf16(b1, qr[d0], p1, 0, 0, 0); }
}
__device__ __forceinline__ int v_st(int k, int c) { const int kk = (k & ~0xC) | ((k & 4) << 1) | ((k & 8) >> 1); return ((kk >> 3) * 4 + (c >> 5)) * 512 + ((kk & 7) * 32 + (c & 31)) * 2; }
__device__ __forceinline__ int v_rd_base(int lane) { return ((lane & 3) << 3) | (((lane >> 2) & 3) << 6) | (((lane >> 4) & 1) << 5) | (((lane >> 5) & 1) << 8); }
constexpr int v_rd_off(int d0, int ks, int half) { return d0 * 512 + ks * 4096 + half * 2048; }
template <int OFF> __device__ __forceinline__ s16x4 tr_read(int vb) {
  s16x4 r; asm volatile("ds_read_b64_tr_b16 %0, %1 offset:%2" : "=&v"(r) : "v"(vb), "i"(OFF) : "memory"); return r;
}
template <int D0> __device__ __forceinline__ void pv_one(f32x16& od, int vb, bf16x8 pa0, bf16x8 pa1, bf16x8 pa2, bf16x8 pa3) {
  const s16x4 l0 = tr_read<v_rd_off(D0, 0, 0)>(vb), h0 = tr_read<v_rd_off(D0, 0, 1)>(vb), l1 = tr_read<v_rd_off(D0, 1, 0)>(vb), h1 = tr_read<v_rd_off(D0, 1, 1)>(vb);
  const s16x4 l2 = tr_read<v_rd_off(D0, 2, 0)>(vb), h2 = tr_read<v_rd_off(D0, 2, 1)>(vb), l3 = tr_read<v_rd_off(D0, 3, 0)>(vb), h3 = tr_read<v_rd_off(D0, 3, 1)>(vb);
  asm volatile("s_waitcnt lgkmcnt(0)" ::: "memory"); SBAR();
#define PK(L, H) (bf16x8){L[0], L[1], L[2], L[3], H[0], H[1], H[2], H[3]}
  od = __builtin_amdgcn_mfma_f32_32x32x16_bf16(pa0, PK(l0, h0), od, 0, 0, 0);
  od = __builtin_amdgcn_mfma_f32_32x32x16_bf16(pa1, PK(l1, h1), od, 0, 0, 0);
  od = __builtin_amdgcn_mfma_f32_32x32x16_bf16(pa2, PK(l2, h2), od, 0, 0, 0);
  od = __builtin_amdgcn_mfma_f32_32x32x16_bf16(pa3, PK(l3, h3), od, 0, 0, 0);
#undef PK
}
__device__ __forceinline__ void pv_d0(f32x16* o, int vb, bf16x8 pa0, bf16x8 pa1, bf16x8 pa2, bf16x8 pa3) {
  pv_one<0>(o[0], vb, pa0, pa1, pa2, pa3); pv_one<1>(o[1], vb, pa0, pa1, pa2, pa3); pv_one<2>(o[2], vb, pa0, pa1, pa2, pa3); pv_one<3>(o[3], vb, pa0, pa1, pa2, pa3);
}

struct AttnArgs {
  const bf16_t* Q; const bf16_t* K; const bf16_t* V; bf16_t* O; float* lse;
  int ldq, ldk, ldo, ldl;
  int q0, kt0, nt;
  int lL, ldil;
  float nsl;
  int rows;
  const float* qg = nullptr;
};

template <int MODE>
__device__ __forceinline__ void apply_bias(f32x16& p0, f32x16& p1, const int kt, const int rho_q, const int hi, const float nsl, const int lL,
                                           const float* tbl, const int qrow_g, const int qc, const int r0, const int c0) {
  if constexpr (MODE == 1 || MODE == 2) {
    const float fd = (float)(kt - rho_q + 4 * hi);
    bool tile_ok = true;
    if constexpr (MODE == 2) tile_ok = ((kt >> lL) == (rho_q >> lL));
#pragma unroll
    for (int r = 0; r < 16; ++r) {
      const float c = (float)((r & 3) + 8 * (r >> 2));
      const float d0 = fabsf(fd + c), d1 = fabsf(fd + (c + 32.f));
      float v0 = fmaf(nsl, d0, p0[r]), v1 = fmaf(nsl, d1, p1[r]);
      if constexpr (MODE == 2) { v0 = (tile_ok && d0 <= 64.f) ? v0 : MASKV; v1 = (tile_ok && d1 <= 64.f) ? v1 : MASKV; }
      p0[r] = v0; p1[r] = v1;
    }
  } else if constexpr (MODE == 3) {
    const int krow = kt >> 6; const bool rowok = (krow >= r0) && (krow < r0 + 8);
    int dr = krow - lL + 7; dr = min(max(dr, 0), 14);
    const float* trow = tbl + dr * 128 + qrow_g;
    const unsigned mlo = rowok ? (unsigned)qc : 0u, mhi = rowok ? (unsigned)c0 : 0u;
#pragma unroll
    for (int r = 0; r < 16; ++r) {
      const int cc = (r & 3) + 8 * (r >> 2);
      const float b0 = trow[cc], b1 = trow[cc + 32];
      p0[r] = (mlo & (1u << cc)) ? p0[r] + b0 : MASKV; p1[r] = (mhi & (1u << cc)) ? p1[r] + b1 : MASKV;
    }
  }
}

template <int MODE, int FIX = 0>
__device__ __forceinline__ void attn_body(const AttnArgs a, char* lds, float& m_io, float& l_io, unsigned long long& zmask) {
  const int tid = otid(), wid = __builtin_amdgcn_readfirstlane(tid >> 6), lane = tid & 63, r32 = lane & 31, hi = lane >> 5;
  bf16_t* V_lds = (bf16_t*)lds; bf16_t* K_lds = (bf16_t*)(lds + 2 * SHM_V);
  float* wsl = (float*)(lds + 2 * SHM_V + 2 * SHM_K) + wid * 64; float* li_l = wsl; float* al_l = wsl + 32;
  const float* tbl = (const float*)(lds + ATT_TBL_OFF);
  float m_reg = FIX ? m_io : M_INIT, l_reg = FIX ? l_io : 0.f; f32x16 o[4] = {}; bf16x8 qr[8];
  const int Lm = (1 << a.lL) - 1, lL = a.lL, ldil = a.ldil;
#define TOK(rho) ((((rho) & Lm) << ldil) + ((rho) >> lL))
  const int rho_q = a.q0 + wid * 32 + r32;
  const bf16_t* Qw = a.Q + (long)TOK(rho_q) * a.ldq + hi * 8;
#pragma unroll
  for (int d0 = 0; d0 < 8; ++d0) qr[d0] = *reinterpret_cast<const bf16x8*>(Qw + d0 * 16);
  if constexpr (MODE == 0) {
    float ssq = 0.f;
#pragma unroll
    for (int d0 = 0; d0 < 8; ++d0) { const u32x4 w = *reinterpret_cast<const u32x4*>(&qr[d0]);
#pragma unroll
      for (int k = 0; k < 4; ++k) { const float x0 = bflo(w[k]), x1 = bfhi(w[k]); ssq += x0 * x0 + x1 * x1; } }
    { auto rr = __builtin_amdgcn_permlane32_swap(__float_as_uint(ssq), __float_as_uint(ssq), false, false);
      ssq = __uint_as_float(rr[0]) + __uint_as_float(rr[1]); }
    const float rs = rsqrtf(ssq * (1.f / 128.f) + EPS);
    const int pos = rho_q & (a.rows - 1);
    const float prow = (float)(pos >> 6), pcol = (float)(pos & 63);
#pragma unroll
    for (int d0 = 0; d0 < 8; ++d0) {
      const float pp = (d0 < 4) ? prow : pcol;
      u32x4 w = *reinterpret_cast<const u32x4*>(&qr[d0]);
      const float* gp = a.qg + d0 * 16 + hi * 8;
      const f32x4 g0 = *(const f32x4*)gp, g1 = *(const f32x4*)(gp + 4);
      const float gg[8] = {g0[0], g0[1], g0[2], g0[3], g1[0], g1[1], g1[2], g1[3]};
#pragma unroll
      for (int k = 0; k < 4; ++k) {
        const float fr = exp2f(-(float)((d0 & 3) * 8 + hi * 4 + k) * (13.287712379549449f / 32.f)) * 0.15915494309189535f;
        const float rev = pp * fr;
        const float sn = __builtin_amdgcn_sinf(rev), cs = __builtin_amdgcn_cosf(rev);
        const float x0 = bflo(w[k]) * rs * gg[2 * k], x1 = bfhi(w[k]) * rs * gg[2 * k + 1];
        w[k] = cvtpk(x0 * cs - x1 * sn, x0 * sn + x1 * cs);
      }
      qr[d0] = *reinterpret_cast<bf16x8*>(&w);
    }
  }
  int qrow_g = 0, qc = 0, r0 = 0, c0 = 0, lLb = lL;
  if constexpr (MODE == 3) {
    const int qrg = (a.q0 + wid * 32) >> 6, qcol = ((wid & 1) << 5) + r32;
    r0 = min(max(qrg - 4, 0), a.rows - 8);
    const int cw = min(max(qcol - 8, 0), 48);
    const unsigned long long cm = (0xffffull << cw) >> (4 * hi);
    qc = (int)(unsigned)cm; c0 = (int)(unsigned)(cm >> 32);
    qrow_g = 63 - qcol + 4 * hi; lLb = qrg;
  }
  const float nsl = a.nsl;
  const int sr = tid >> 4, sc = (tid & 15) * 8, vst0 = v_st(sr, sc), vst1 = v_st(32 + sr, sc);
  const int vb0 = (int)(uintptr_t)V_lds + v_rd_base(lane);
  const char* Kp = (const char*)a.K; const char* Vp = (const char*)a.V; const int ldk = a.ldk;
  bf16x8 vs0, vs1, ks0, ks1;
#define SLOAD(k0) do { const unsigned t0_ = (unsigned)(TOK((k0) + sr) * ldk + sc) * 2u, t1_ = (unsigned)(TOK((k0) + 32 + sr) * ldk + sc) * 2u; \
    vs0 = *reinterpret_cast<const bf16x8*>(Vp + t0_); vs1 = *reinterpret_cast<const bf16x8*>(Vp + t1_); \
    ks0 = *reinterpret_cast<const bf16x8*>(Kp + t0_); ks1 = *reinterpret_cast<const bf16x8*>(Kp + t1_); } while (0)
#define SWRITE(b, V0, V1, K0, K1) do { *(bf16x8*)((char*)V_lds + (b) * SHM_V + vst0) = V0; \
    *(bf16x8*)((char*)V_lds + (b) * SHM_V + vst1) = V1; const int kc_ = sc * 2; \
    *(bf16x8*)((char*)K_lds + (b) * SHM_K + KSWZ(sr, kc_)) = K0; \
    *(bf16x8*)((char*)K_lds + (b) * SHM_K + KSWZ(32 + sr, kc_)) = K1; } while (0)
#define SWAIT() asm volatile("s_waitcnt vmcnt(0)" ::: "memory")
#define RESC(al) do { if (__any((al) < 1.f)) { if (hi == 0) al_l[r32] = (al); asm volatile("s_waitcnt lgkmcnt(0)" ::: "memory"); \
    for (int d = 0; d < 4; ++d) for (int r = 0; r < 16; ++r) o[d][r] *= al_l[crow(r, hi)]; } } while (0)
#define BIAS(P0, P1, kt) apply_bias<MODE>(P0, P1, (kt), rho_q, hi, nsl, lLb, tbl, qrow_g, qc, r0, c0)
#define PSM(P0, P1, MN, AL) do { if constexpr (FIX) { partialSM_fix(P0, P1, m_reg); AL = 1.f; } else partialSM(P0, P1, m_reg, MN, AL); } while (0)
#define FSM(P0, P1, AL) do { if constexpr (FIX) finishSM_fix(P0, P1, pa0, pa1, pa2, pa3); else finishSM(P0, P1, AL, l_reg, pa0, pa1, pa2, pa3); } while (0)
#define RESCX(AL) do { if constexpr (!FIX) RESC(AL); } while (0)
  f32x16 pA0, pA1, pB0, pB1; float mnA, mnB, alA, alB; bf16x8 pa0, pa1, pa2, pa3; const int NT = a.nt; const int kt0 = a.kt0;
  const int qw_u = __builtin_amdgcn_readfirstlane(a.q0 + wid * 32), r0_u = __builtin_amdgcn_readfirstlane(r0);
  const int d0t = a.q0 >> 6;
#define KT(j) ((MODE == 1 && !FIX) ? 64 * ((j) < 4 ? d0t + (j) : ((j) - 4 < d0t ? (j) - 4 : (j))) : kt0 + (j) * KVBLK)
#define ACT(j, kt) ((MODE == 0) ? true : (MODE == 1) ? true : (MODE == 2) ? ((((kt) >> lL) == (qw_u >> lL)) && ((kt) <= qw_u + 95) && ((kt) + 127 >= qw_u)) : ((((kt) >> 6) >= r0_u) && (((kt) >> 6) < r0_u + 8)))
#define PSMZ(P0, P1, MN, AL, ACTV, J) do { if constexpr (MODE == 1 && !FIX) { if (partialSM_z(P0, P1, m_reg, MN, AL)) zmask |= 1ull << ((J) >> 6); } else PSM(P0, P1, MN, AL); } while (0)
  if constexpr (MODE == 1 && !FIX) zmask = 0ull;
  bool actA, actB;
  { const int k_ = KT(0); SLOAD(k_); } SWAIT(); SWRITE(0, vs0, vs1, ks0, ks1); __syncthreads();
  { const int k_ = KT(0); actA = ACT(0, k_);
    if (actA) { qkt(pA0, pA1, K_lds, qr, r32, hi); BIAS(pA0, pA1, k_); PSMZ(pA0, pA1, mnA, alA, actA, k_); } else alA = 1.f; }
  { const int k_ = KT(1); SLOAD(k_); }
  SWAIT(); SWRITE(1, vs0, vs1, ks0, ks1); __syncthreads();
  for (int j = 1; j + 1 < NT; j += 2) {
    const int kj = KT(j), kj1 = KT(j + 1), kj2 = KT(j + 2);
    actB = ACT(j, kj);
    SBAR(); if (actB) qkt(pB0, pB1, (bf16_t*)((char*)K_lds + SHM_K), qr, r32, hi);
    if (actA) FSM(pA0, pA1, alA); SBAR();
    SLOAD(kj1); SBAR();
    if (actA) pv_d0(o, vb0, pa0, pa1, pa2, pa3);
    if (actB) { BIAS(pB0, pB1, kj); PSMZ(pB0, pB1, mnB, alB, actB, kj); } else alB = 1.f;
    __syncthreads(); SWAIT(); SWRITE(0, vs0, vs1, ks0, ks1);
    RESCX(alB); __syncthreads();
    actA = ACT(j + 1, kj1);
    SBAR(); if (actA) qkt(pA0, pA1, K_lds, qr, r32, hi);
    if (actB) FSM(pB0, pB1, alB); SBAR();
    SLOAD(kj2); SBAR();
    if (actB) pv_d0(o, vb0 + (int)SHM_V, pa0, pa1, pa2, pa3);
    if (actA) { BIAS(pA0, pA1, kj1); PSMZ(pA0, pA1, mnA, alA, actA, kj1); } else alA = 1.f;
    __syncthreads(); SWAIT(); SWRITE(1, vs0, vs1, ks0, ks1);
    RESCX(alA); __syncthreads();
  }
  { const int kl = KT(NT - 1);
    actB = ACT(NT - 1, kl);
    SBAR(); if (actB) qkt(pB0, pB1, (bf16_t*)((char*)K_lds + SHM_K), qr, r32, hi);
    if (actA) FSM(pA0, pA1, alA); SBAR();
    if (actA) pv_d0(o, vb0, pa0, pa1, pa2, pa3);
    if (actB) { BIAS(pB0, pB1, kl); PSMZ(pB0, pB1, mnB, alB, actB, kl); } else alB = 1.f; }
  __syncthreads(); RESCX(alB);
  if (actB) { FSM(pB0, pB1, alB); SBAR();
    pv_d0(o, vb0 + (int)SHM_V, pa0, pa1, pa2, pa3); }
#undef KT
#undef PSMZ
#undef ACT
  if (hi == 0) li_l[r32] = l_reg; asm volatile("s_waitcnt lgkmcnt(0)" ::: "memory");
#pragma unroll
  for (int r = 0; r < 16; ++r) {
    const int orow = crow(r, hi); const float rli = __builtin_amdgcn_rcpf(li_l[orow]);
    bf16_t* Ow = a.O + (long)TOK(a.q0 + wid * 32 + orow) * a.ldo + r32;
#pragma unroll
    for (int d0 = 0; d0 < 4; ++d0) Ow[d0 * 32] = (bf16_t)(cvtpk(o[d0][r] * rli, 0.f) & 0xffffu);
  }
  if (a.lse != nullptr && hi == 0) a.lse[(long)TOK(rho_q) * a.ldl] = m_reg * SCALE + __logf(l_reg);
  if constexpr (!FIX) { m_io = m_reg; l_io = l_reg; }
  if constexpr (MODE == 1 && !FIX) {
    asm volatile("" ::: "memory");
    if (lane == 0) { ((unsigned*)wsl)[0] = (unsigned)zmask; ((unsigned*)wsl)[1] = (unsigned)(zmask >> 32); }
  }
  __syncthreads();
  if constexpr (MODE == 1 && !FIX) {
    unsigned zl = ~0u, zh = ~0u;
#pragma unroll
    for (int w = 0; w < 8; ++w) { const unsigned* q = (const unsigned*)((const float*)(lds + 2 * SHM_V + 2 * SHM_K) + w * 64); zl &= q[0]; zh &= q[1]; }
    zmask = ((unsigned long long)(unsigned)__builtin_amdgcn_readfirstlane((int)zh) << 32) | (unsigned)__builtin_amdgcn_readfirstlane((int)zl);
  }
#undef TOK
#undef SLOAD
#undef SWRITE
#undef SWAIT
#undef RESC
#undef BIAS
#undef PSM
#undef FSM
#undef RESCX
}

__device__ __forceinline__ int xcd_remap(int L, int n) { return (L & 7) * (n >> 3) + (L >> 3); }

__device__ __forceinline__ void attn_even(const Params& p, int S, int lS, int tc, int ci, char* lds) {
  char* ws = p.ws; const bf16_t* proj = (const bf16_t*)(ws + OFF_PROJ); bf16_t* tmp = (bf16_t*)(ws + OFF_TMP); bf16_t* ao = (bf16_t*)(ws + OFF_AO);
  bf16_t* tmp2 = (bf16_t*)(ws + OFF_PROJ) + (size_t)tc * EVN;
  const int nseq = tc / S, nqb = S / 256, lq = lS - 8;
  const int n1 = nseq * 4 * nqb;
  const int wid_ = otid() >> 6, lane_ = otid() & 63;
  const float* lv = p.ev_lambda;
  float s1 = lv[lane_] * lv[128 + lane_] + lv[64 + lane_] * lv[192 + lane_];
  float s2 = lv[256 + lane_] * lv[384 + lane_] + lv[320 + lane_] * lv[448 + lane_];
  s1 = wave_sum(s1); s2 = wave_sum(s2);
  const float lam = __expf(s1) - __expf(s2) + 0.2f;
  const f32x4 g4 = *(const f32x4*)(p.ev_subln_g + lane_ * 4);
  for (int L = obid(); L < n1; L += gridDim.x) {
    const int u = xcd_remap(L, n1); const int qb = u & (nqb - 1), h = (u >> lq) & 3, b = u >> (lq + 2);
    const bf16_t* base = proj + (size_t)b * S * EVN;
    float m_s = 0.f, l_s = 1.f; unsigned long long zm = 0ull;
#pragma unroll
    for (int c = 0; c < 2; ++c) {
      AttnArgs a;
      a.Q = base + h * 256 + c * 128; a.K = base + 1024 + h * 256 + c * 128; a.V = base + 2048 + h * 256;
      a.O = (c == 0 ? tmp : tmp2) + (size_t)b * S * 1024 + h * 256; a.lse = nullptr;
      a.ldq = EVN; a.ldk = EVN; a.ldo = 1024; a.ldl = 0; a.q0 = qb * 256; a.kt0 = 0; a.nt = S / 64; a.lL = lS; a.ldil = 0;
      a.nsl = -exp2f(-2.f * (float)(h + 1)) / SCALE; a.rows = 0;
      attn_body<1, 0>(a, lds, m_s, l_s, zm);
      a.V += 128; a.O += 128;
      {
        const int ntt = S / 64;
        unsigned long long nz = ~zm; if (ntt < 64) nz &= ((1ull << ntt) - 1ull);
        int t_lo = __builtin_ctzll(nz), t_hi = 64 - __builtin_clzll(nz);
        if ((t_hi - t_lo) & 1) { if (t_hi < ntt) ++t_hi; else --t_lo; }
        a.kt0 = t_lo * 64; a.nt = t_hi - t_lo;
      }
      attn_body<1, 1>(a, lds, m_s, l_s, zm);
    }
    asm volatile("s_waitcnt vmcnt(0)" ::: "memory");
    {
      const size_t tok0 = (size_t)b * S + qb * 256 + wid_ * 32;
#pragma unroll 1
      for (int i = 0; i < 32; i += 4) {
        u32x2 xa[4], xb[4];
#pragma unroll
        for (int k = 0; k < 4; ++k) { const size_t off = (tok0 + i + k) * 1024 + h * 256 + lane_ * 4; xa[k] = *(const u32x2*)(tmp + off); xb[k] = *(const u32x2*)(tmp2 + off); }
#pragma unroll
        for (int k = 0; k < 4; ++k) {
          const float o0 = bflo(xa[k][0]) - lam * bflo(xb[k][0]), o1 = bfhi(xa[k][0]) - lam * bfhi(xb[k][0]), o2 = bflo(xa[k][1]) - lam * bflo(xb[k][1]), o3 = bfhi(xa[k][1]) - lam * bfhi(xb[k][1]);
          float ss = o0 * o0 + o1 * o1 + o2 * o2 + o3 * o3; ss = wave_sum(ss);
          const float rs = rsqrtf(ss * (1.f / 256.f) + EPS) * 0.8f;
          const u32x2 wv = {cvtpk(o0 * rs * g4[0], o1 * rs * g4[1]), cvtpk(o2 * rs * g4[2], o3 * rs * g4[3])};
          *(u32x2*)(ao + (tok0 + i + k) * DM + h * 256 + lane_ * 4) = wv;
        }
      }
    }
  }
  const int n2 = nseq * 8 * nqb; const int rows = S / 64;
  float* tbl = (float*)(lds + ATT_TBL_OFF);
  const int grp = obid() & 7, per = n2 >> 3;
  unsigned* wq = (unsigned*)(ws + OFF_WQ) + (size_t)(ci * 8 + grp) * 64;
  volatile unsigned* ubx = (volatile unsigned*)(lds + ATT_TBL_OFF + 15 * 128 * 4);
  for (;;) {
    if (otid() == 0) *ubx = __hip_atomic_fetch_add(wq, 1u, __ATOMIC_RELAXED, __HIP_MEMORY_SCOPE_AGENT);
    __syncthreads();
    const int kq = __builtin_amdgcn_readfirstlane((int)*ubx);
    if (kq >= per) break;
    const int u = grp * per + kq; const int qb = u & (nqb - 1), hd = (u >> lq) & 7, b = u >> (lq + 3);
    for (int i = otid(); i < 15 * 31; i += NTHREADS) { const int dr = i / 31, dc = i - dr * 31; tbl[dr * 128 + 48 + dc] = p.ev_rpb[hd * (15 * 31) + i] * (1.f / SCALE); }
    const bf16_t* base = proj + (size_t)b * S * EVN;
    const int R = qb * 4;
    int t0 = min(max(R - 4, 0), rows - 8), t1 = min(max(R - 1, 0), rows - 8) + 8;
    if ((t1 - t0) & 1) { if (t1 < rows) ++t1; else --t0; }
    AttnArgs a;
    a.Q = base + 3072 + hd * 128; a.K = base + 4096 + hd * 128; a.V = base + 5120 + hd * 128;
    a.O = ao + (size_t)b * S * DM + 1024 + hd * 128; a.lse = nullptr;
    a.ldq = EVN; a.ldk = EVN; a.ldo = DM; a.ldl = 0; a.q0 = qb * 256; a.kt0 = t0 * 64; a.nt = t1 - t0; a.lL = lS; a.ldil = 0;
    a.nsl = 0.f; a.rows = rows;
    { float ms_, ls_; unsigned long long zm_ = 0ull; attn_body<3>(a, lds, ms_, ls_, zm_); }
  }
}

__device__ __forceinline__ void attn_odd(const Params& p, int S, int lS, int tc, char* lds) {
  char* ws = p.ws; bf16_t* proj = (bf16_t*)(ws + OFF_PROJ); bf16_t* ao = (bf16_t*)(ws + OFF_AO);
  float* lseb = (float*)(ws + OFF_LSE);
  const int nseq = tc / S, nqb = S / 256;
  const int n1 = nseq * 12 * nqb;
  for (int L = obid(); L < n1; L += gridDim.x) {
    const int u = xcd_remap(L, n1); const int qb = u % nqb, hq = (u / nqb) % 12, b = u / (nqb * 12);
    const int kvh = hq / 3;
    const bf16_t* base = proj + (size_t)b * S * ODN;
    AttnArgs a;
    a.Q = base + 4608 + hq * 128; a.K = base + 6144 + kvh * 128; a.V = base + 6656 + kvh * 128;
    a.O = ao + (size_t)b * S * DM + 512 + hq * 128; a.lse = nullptr;
    a.ldq = ODN; a.ldk = ODN; a.ldo = DM; a.ldl = 0; a.q0 = qb * 256; a.kt0 = 0; a.nt = S / 64; a.lL = lS; a.ldil = 0; a.nsl = 0.f; a.rows = S; a.qg = p.od_qk_norm_g;
    { float ms_, ls_; unsigned long long zm_ = 0ull; attn_body<0>(a, lds, ms_, ls_, zm_); }
  }
  for (int L = obid(); L < n1; L += gridDim.x) {
    const int u = xcd_remap(L, n1); const int qb = u % nqb, gj = (u / nqb) % 12, b = u / (nqb * 12);
    const int g = gj >> 2, j = gj & 3;
    bf16_t* base = proj + (size_t)b * S * ODN;
    const int q0 = qb * 256;
    int k0 = max(q0 - 64, 0), k1 = min(q0 + 320, S);
    if (((k1 - k0) >> 6) & 1) { if (k1 + 64 <= S) k1 += 64; else k0 -= 64; }
    AttnArgs a;
    a.Q = base + g * 512 + j * 128; a.K = base + 1536 + g * 512 + j * 128; a.V = base + 3072 + g * 512 + j * 128;
    a.O = base + g * 512 + j * 128; a.lse = lseb + (size_t)g * tc * 4 + (size_t)b * S * 4 + j;
    a.ldq = ODN; a.ldk = ODN; a.ldo = ODN; a.ldl = 4; a.q0 = q0; a.kt0 = k0; a.nt = (k1 - k0) >> 6; a.ldil = 2 * g; a.lL = lS - 2 * g;
    a.nsl = -exp2f(-8.f * (float)(gj + 1) / 12.f) * (float)(1 << (2 * g)) / SCALE; a.rows = 0;
    { float ms_, ls_; unsigned long long zm_ = 0ull; attn_body<2>(a, lds, ms_, ls_, zm_); }
  }
}

__device__ __forceinline__ void combine_diff(const Params& p, int tc) {
  char* ws = p.ws; const bf16_t* t1 = (const bf16_t*)(ws + OFF_TMP); const bf16_t* t2 = (const bf16_t*)(ws + OFF_PROJ) + (size_t)tc * EVN; bf16_t* ao = (bf16_t*)(ws + OFF_AO);
  const int tid_ = otid(); const int lane = tid_ & 63; const int gw = obid() * 8 + (tid_ >> 6), nw = gridDim.x * 8;
  const float* lv = p.ev_lambda;
  float s1 = lv[lane] * lv[128 + lane] + lv[64 + lane] * lv[192 + lane];
  float s2 = lv[256 + lane] * lv[384 + lane] + lv[320 + lane] * lv[448 + lane];
  s1 = wave_sum(s1); s2 = wave_sum(s2);
  const float lam = __expf(s1) - __expf(s2) + 0.2f;
  const f32x4 g4 = *(const f32x4*)(p.ev_subln_g + lane * 4);
  for (int tok = gw; tok < tc; tok += nw) {
    u32x2 a[4], b[4];
#pragma unroll
    for (int h = 0; h < 4; ++h) { const size_t off = (size_t)tok * 1024 + h * 256 + lane * 4; a[h] = *(const u32x2*)(t1 + off); b[h] = *(const u32x2*)(t2 + off); }
#pragma unroll
    for (int h = 0; h < 4; ++h) {
      const float o0 = bflo(a[h][0]) - lam * bflo(b[h][0]), o1 = bfhi(a[h][0]) - lam * bfhi(b[h][0]), o2 = bflo(a[h][1]) - lam * bflo(b[h][1]), o3 = bfhi(a[h][1]) - lam * bfhi(b[h][1]);
      float ss = o0 * o0 + o1 * o1 + o2 * o2 + o3 * o3; ss = wave_sum(ss);
      const float rs = rsqrtf(ss * (1.f / 256.f) + EPS) * 0.8f;
      const u32x2 wv = {cvtpk(o0 * rs * g4[0], o1 * rs * g4[1]), cvtpk(o2 * rs * g4[2], o3 * rs * g4[3])};
      *(u32x2*)(ao + (size_t)tok * DM + h * 256 + lane * 4) = wv;
    }
  }
}
__device__ __forceinline__ void combine_dil(const Params& p, int tc) {
  char* ws = p.ws; const bf16_t* proj = (const bf16_t*)(ws + OFF_PROJ); const float* lseb = (const float*)(ws + OFF_LSE); bf16_t* ao = (bf16_t*)(ws + OFF_AO);
  const int tid_ = otid(); const int lane = tid_ & 63; const int gw = obid() * 8 + (tid_ >> 6), nw = gridDim.x * 8;
  const int j = lane >> 4;
  for (int tok = gw; tok < tc; tok += nw) {
    const float l0 = lseb[(size_t)tok * 4 + j], l1 = lseb[(size_t)tc * 4 + (size_t)tok * 4 + j], l2 = lseb[(size_t)2 * tc * 4 + (size_t)tok * 4 + j];
    const float mx = fmaxf(l0, fmaxf(l1, l2)); const float e0 = __expf(l0 - mx), e1 = __expf(l1 - mx), e2 = __expf(l2 - mx);
    const float inv = 1.f / (e0 + e1 + e2); const float a0 = e0 * inv, a1 = e1 * inv, a2 = e2 * inv;
    const size_t off = (size_t)tok * ODN + lane * 8;
    const u32x4 x0 = *(const u32x4*)(proj + off), x1 = *(const u32x4*)(proj + off + 512), x2 = *(const u32x4*)(proj + off + 1024);
    u32x4 w;
#pragma unroll
    for (int i = 0; i < 4; ++i) {
      const float lo = a0 * bflo(x0[i]) + a1 * bflo(x1[i]) + a2 * bflo(x2[i]);
      const float hi = a0 * bfhi(x0[i]) + a1 * bfhi(x1[i]) + a2 * bfhi(x2[i]);
      w[i] = cvtpk(lo, hi);
    }
    *(u32x4*)(ao + (size_t)tok * DM + lane * 8) = w;
  }
}
__device__ __forceinline__ void rope_pass(const Params& p, int S, int tc) {
  bf16_t* proj = (bf16_t*)(p.ws + OFF_PROJ);
  const int tid_ = otid(); const int lane = tid_ & 63; const int gw = obid() * 8 + (tid_ >> 6), nw = gridDim.x * 8;
  const float gk0 = p.od_qk_norm_g[128 + 2 * lane], gk1 = p.od_qk_norm_g[128 + 2 * lane + 1];
  const float freq = exp2f(-(float)(lane & 31) * (13.287712379549449f / 32.f)) * 0.15915494309189535f;
  for (int tok = gw; tok < tc; tok += 2 * nw) {
    const int tok2 = (tok + nw < tc) ? tok + nw : tok;
    unsigned* ptr = (unsigned*)(proj + (size_t)tok * ODN + 6144) + lane;
    unsigned* ptr2 = (unsigned*)(proj + (size_t)tok2 * ODN + 6144) + lane;
    unsigned x[4], y[4];
#pragma unroll
    for (int hh = 0; hh < 4; ++hh) { x[hh] = ptr[hh * 64]; y[hh] = ptr2[hh * 64]; }
#pragma unroll
    for (int t = 0; t < 2; ++t) {
      const int pos = (t == 0 ? tok : tok2) & (S - 1);
      const float pp = (float)((lane < 32) ? (pos >> 6) : (pos & 63));
      const float rev = pp * freq;
      const float sn = __builtin_amdgcn_sinf(rev), cs = __builtin_amdgcn_cosf(rev);
      if (t == 1 && tok2 == tok) break;
#pragma unroll
      for (int hh = 0; hh < 4; ++hh) {
        const unsigned xv = (t == 0) ? x[hh] : y[hh];
        const float x0 = bflo(xv), x1 = bfhi(xv);
        float ss = x0 * x0 + x1 * x1; ss = wave_sum(ss);
        const float rs = rsqrtf(ss * (1.f / 128.f) + EPS);
        const float y0 = x0 * rs * gk0, y1 = x1 * rs * gk1;
        (t == 0 ? ptr : ptr2)[hh * 64] = cvtpk(y0 * cs - y1 * sn, y0 * sn + y1 * cs);
      }
    }
  }
}

__device__ __forceinline__ void rope_k_local(const Params& p, int S, int tc) {
  bf16_t* proj = (bf16_t*)(p.ws + OFF_PROJ);
  const int tid_ = otid(); const int lane = tid_ & 63, wv = tid_ >> 6;
  const float gk0 = p.od_qk_norm_g[128 + 2 * lane], gk1 = p.od_qk_norm_g[128 + 2 * lane + 1];
  const float freq = exp2f(-(float)(lane & 31) * (13.287712379549449f / 32.f)) * 0.15915494309189535f;
  const int nM = tc / BM, nN = ODN / BM;
  int pm, pn;
  for (int i = 0; gemm_next(i, nM, nN, pm, pn); ++i) {
    if (pn != 24 && pn != 25) continue;
    for (int t0 = wv * 64; t0 < wv * 64 + 64; t0 += 4) {
      unsigned x[4]; unsigned* ptr[4]; int posv[4];
#pragma unroll
      for (int k = 0; k < 4; ++k) {
        const int t = t0 + k, row = t >> 1, hd = t & 1; const int tok = pm * BM + row;
        ptr[k] = (unsigned*)(proj + (size_t)tok * ODN + pn * BM + hd * 128) + lane; posv[k] = tok & (S - 1);
        x[k] = *ptr[k];
      }
#pragma unroll
      for (int k = 0; k < 4; ++k) {
        const float pp = (float)((lane < 32) ? (posv[k] >> 6) : (posv[k] & 63));
        const float rev = pp * freq;
        const float sn = __builtin_amdgcn_sinf(rev), cs = __builtin_amdgcn_cosf(rev);
        const float x0 = bflo(x[k]), x1 = bfhi(x[k]);
        float ss = x0 * x0 + x1 * x1; ss = wave_sum(ss);
        const float rs = rsqrtf(ss * (1.f / 128.f) + EPS);
        const float y0 = x0 * rs * gk0, y1 = x1 * rs * gk1;
        *ptr[k] = cvtpk(y0 * cs - y1 * sn, y0 * sn + y1 * cs);
      }
    }
  }
}

#define XB_TMO      128
#define XB_XCNT(j)  (256  + 64 * (j))
#define XB_XSUB(j)  (1280 + 64 * (j))
#define XB_XGEN(j)  (2304 + 64 * (j))
#define XB_TOP      3328
#define XB_TOPGEN   3392
#define XB_SPIN_CAP (1u << 22)
__device__ __forceinline__ unsigned xb_ld(unsigned* p)              { return __hip_atomic_load(p, __ATOMIC_RELAXED, __HIP_MEMORY_SCOPE_AGENT); }
__device__ __forceinline__ unsigned xb_add(unsigned* p, unsigned v) { return __hip_atomic_fetch_add(p, v, __ATOMIC_RELAXED, __HIP_MEMORY_SCOPE_AGENT); }
__device__ __forceinline__ unsigned xb_xcc_id() { return (unsigned)__builtin_amdgcn_s_getreg((3 << 11) | 20) & 0xFu; }
#define XB_SPIN(cond, bar) do { unsigned _sp = 0; while (cond) { __builtin_amdgcn_s_sleep(1); \
    if ((++_sp & 255u) == 0u) { if (xb_ld(&(bar)[XB_TMO])) break; if (_sp > XB_SPIN_CAP) { atomicAdd(&(bar)[XB_TMO], 1u); break; } } } } while (0)
struct XcdBarrier { unsigned* bar; unsigned x; volatile LAS unsigned* st; };
__device__ __forceinline__ XcdBarrier xcd_barrier_post(unsigned* bar, volatile LAS unsigned* st) {
  XcdBarrier b; b.bar = bar; b.x = xb_xcc_id(); b.st = st;
  if (threadIdx.x == 0) (void)xb_add(&bar[XB_XCNT(b.x)], 1u);
  return b;
}
__device__ __forceinline__ void xcd_barrier_complete(unsigned* bar, unsigned x, unsigned& nloc, unsigned& nx) {
  const unsigned G = gridDim.x * gridDim.y * gridDim.z;
  unsigned sum, cnt, mine, sp = 0u;
  for (;;) {
    sum = 0u; cnt = 0u; mine = 0u;
#pragma unroll
    for (unsigned j = 0; j < 16; ++j) { const unsigned c = xb_ld(&bar[XB_XCNT(j)]); sum += c; cnt += (c > 0u) ? 1u : 0u; mine = (j == x) ? c : mine; }
    if (sum == G) break;
    __builtin_amdgcn_s_sleep(1);
    if ((++sp & 255u) == 0u) { if (xb_ld(&bar[XB_TMO])) break; if (sp > XB_SPIN_CAP) { atomicAdd(&bar[XB_TMO], 1u); break; } }
  }
  nloc = mine > 0u ? mine : 1u; nx = cnt > 0u ? cnt : 1u;
}
__device__ __forceinline__ void xcd_barrier(const XcdBarrier& b) {
  asm volatile("s_waitcnt vmcnt(0)" ::: "memory");
  __syncthreads();
  if (threadIdx.x == 0) {
    unsigned* bar = b.bar;
    __builtin_amdgcn_s_waitcnt(0);
    unsigned nloc = b.st[0], nx = b.st[1];
    if (nloc == 0u) { xcd_barrier_complete(bar, b.x, nloc, nx); b.st[0] = nloc; b.st[1] = nx; }
    const unsigned old = xb_add(&bar[XB_XSUB(b.x)], 1u);
    const unsigned gen = old / nloc;
    if (old + 1u == (gen + 1u) * nloc) {
      __builtin_amdgcn_fence(__ATOMIC_RELEASE, "agent");
      asm volatile("s_waitcnt vmcnt(0)" ::: "memory");
      const unsigned og = xb_add(&bar[XB_TOP], 1u);
      const unsigned tg = og / nx;
      if (og + 1u == (tg + 1u) * nx) xb_add(&bar[XB_TOPGEN], 1u);
      else XB_SPIN(xb_ld(&bar[XB_TOPGEN]) == tg, bar);
      __builtin_amdgcn_fence(__ATOMIC_ACQUIRE, "agent");
      xb_add(&bar[XB_XGEN(b.x)], 1u);
      asm volatile("s_waitcnt vmcnt(0)" ::: "memory");
    } else {
      XB_SPIN(xb_ld(&bar[XB_XGEN(b.x)]) == gen, bar);
      __builtin_amdgcn_fence(__ATOMIC_ACQUIRE, "agent");
      asm volatile("s_waitcnt vmcnt(0)" ::: "memory");
    }
  }
  __syncthreads();
}

constexpr int LDS_BYTES = GEMM_LDS + 16;

__global__ void __launch_bounds__(NTHREADS) mega_fwd(Params p) {
  extern __shared__ __attribute__((aligned(16))) char smem[];
  cg::grid_group grid = cg::this_grid();
  char* ws = p.ws;
  bf16_t* xn = (bf16_t*)(ws + OFF_XN); bf16_t* proj = (bf16_t*)(ws + OFF_PROJ); bf16_t* ao = (bf16_t*)(ws + OFF_AO);
  LAS unsigned char* shm = (LAS unsigned char*)smem;

  volatile LAS unsigned* bst = (volatile LAS unsigned*)((LAS unsigned char*)smem + GEMM_LDS);
  if (threadIdx.x == 0) { bst[0] = 0u; bst[1] = 0u; }
  __syncthreads();
  const XcdBarrier xbar = xcd_barrier_post((unsigned*)(ws + OFF_BAR), bst);
  convert_weights(p, (float*)smem);

  constexpr int NPH = 8;
  float* ssq_all = (float*)(ws + OFF_SSQ);
#pragma unroll 1
  for (int step = 0; step < NCHUNK * 2 * NPH; ++step) {
    const int ci = step / (2 * NPH), rem = step - ci * (2 * NPH), layer = rem / NPH, ph = rem - layer * NPH;
    const int S = (ci == 0) ? 2048 : 4096, lS = (ci == 0) ? 11 : 12;
    const int TC = (ci == 0) ? 16384 : 32768;
    const float* xin = (ci == 0) ? p.x_prompt : p.x_sample;
    float* h = p.out + (size_t)ci * 16384 * DM;
    float* ssq_c = ssq_all + (size_t)ci * 5 * TCMAX;
    bool did = true;
    switch (ph) {
      case 0:
        if (layer == 0) cast_rows(xin, xn, ssq_c, TC); else did = false;
        break;
      case 1: {
        EpiArgs e; e.outb = proj; e.ldc = (layer == 0) ? EVN : ODN; e.res = nullptr; e.outf = nullptr; e.ssq_in = ssq_c + (size_t)(2 * layer) * TCMAX; e.ssq_out = nullptr;
        gemm_phase<0>(xn, (const bf16_t*)(ws + (layer == 0 ? OFF_WINE : OFF_WINO)), TC, (layer == 0) ? EVN : ODN, DM, shm, e);
        if (layer == 1) rope_k_local(p, S, TC);
      } break;
      case 2:
        did = false;
        break;
      case 3:
        if (layer == 0) attn_even(p, S, lS, TC, ci, smem); else attn_odd(p, S, lS, TC, smem);
        break;
      case 4:
        if (layer == 1) combine_dil(p, TC); else did = false;
        break;
      case 5: {
        EpiArgs e; e.outb = xn; e.ldc = 0; e.res = xn; e.outf = nullptr; e.ssq_in = nullptr; e.ssq_out = ssq_c + (size_t)(2 * layer + 1) * TCMAX;
        gemm_phase<1>(ao, (const bf16_t*)(ws + (layer == 0 ? OFF_WOUTE : OFF_WOUTO)), TC, DM, DM, shm, e);
      } break;
      case 6: {
        EpiArgs e; e.outb = proj; e.ldc = FF; e.res = nullptr; e.outf = nullptr; e.ssq_in = ssq_c + (size_t)(2 * layer + 1) * TCMAX; e.ssq_out = nullptr;
        gemm_phase<2>(xn, (const bf16_t*)(ws + OFF_WGU + (size_t)layer * SZ_WGU), TC, 2 * FF, DM, shm, e);
      } break;
      default: {
        EpiArgs e; e.outb = xn; e.ldc = 0; e.res = xn; e.outf = nullptr; e.ssq_in = nullptr; e.ssq_out = ssq_c + (size_t)(2 * layer + 2) * TCMAX;
        gemm_phase<1>(proj, (const bf16_t*)(ws + OFF_WD + (size_t)layer * SZ_WD), TC, DM, FF, shm, e);
      } break;
    }
    if (step == 0) grid.sync();
    else if (did) xcd_barrier(xbar);
    if (ph == NPH - 1 && layer == 1) {
      final_norm_rows(xn, p.final_norm_g, h, TC);
      xcd_barrier(xbar);
    }
  }
}

extern "C" void kernel_launch(void* const* d_in, const int* in_sizes, int n_in, void* d_out, int out_size, void* d_ws, size_t ws_size, hipStream_t stream) {
  static int grid_blocks = 0;
  if (!grid_blocks) {
    if (ws_size < WS_END) { fprintf(stderr, "kernel_launch: workspace too small: %zu < %zu\n", ws_size, (size_t)WS_END); return; }
    if (hipFuncSetAttribute((const void*)mega_fwd, hipFuncAttributeMaxDynamicSharedMemorySize, LDS_BYTES) != hipSuccess) { fprintf(stderr, "hipFuncSetAttribute failed\n"); return; }
    int dev = 0, cus = 0, per_cu = 0;
    hipGetDevice(&dev);
    hipDeviceGetAttribute(&cus, hipDeviceAttributeMultiprocessorCount, dev);
    if (hipOccupancyMaxActiveBlocksPerMultiprocessor(&per_cu, (const void*)mega_fwd, NTHREADS, LDS_BYTES) != hipSuccess || per_cu < 1) { fprintf(stderr, "occupancy query failed\n"); return; }
    int g = cus * per_cu; if (g > 256) g = 256; g &= ~7;
    grid_blocks = g;
  }
  Params p{};
  p.x_prompt = (const float*)d_in[0]; p.x_sample = (const float*)d_in[1]; p.attn_norm_g = (const float*)d_in[2]; p.ev_w_in = (const float*)d_in[3];
  p.ev_lambda = (const float*)d_in[4]; p.ev_subln_g = (const float*)d_in[5]; p.ev_rpb = (const float*)d_in[6]; p.ev_w_out = (const float*)d_in[7];
  p.od_w_in = (const float*)d_in[8]; p.od_qk_norm_g = (const float*)d_in[9]; p.od_w_out = (const float*)d_in[10]; p.ffn_norm_g = (const float*)d_in[11];
  p.ffn_w_gate = (const float*)d_in[12]; p.ffn_w_up = (const float*)d_in[13]; p.ffn_w_down = (const float*)d_in[14]; p.final_norm_g = (const float*)d_in[15];
  p.out = (float*)d_out; p.ws = (char*)d_ws;
  if (hipMemsetAsync((char*)d_ws + OFF_BAR, 0, ZERO_BYTES, stream) != hipSuccess) { fprintf(stderr, "memset failed\n"); return; }
  void* args[] = {&p};
  hipError_t e = hipLaunchCooperativeKernel((const void*)mega_fwd, dim3(grid_blocks), dim3(NTHREADS), args, LDS_BYTES, stream);
  if (e != hipSuccess) fprintf(stderr, "cooperative launch failed: %s (grid %d)\n", hipGetErrorString(e), grid_blocks);
}
```

```cpp
#include <hip/hip_runtime.h>
#include <hip/hip_cooperative_groups.h>
#include <cstdio>
#include <cstdint>
namespace cg = cooperative_groups;

typedef unsigned short bf16_t;
typedef short bf16x8 __attribute__((ext_vector_type(8)));
typedef short s16x4 __attribute__((ext_vector_type(4)));
typedef float f32x4 __attribute__((ext_vector_type(4)));
typedef float f32x16 __attribute__((ext_vector_type(16)));
typedef unsigned u32x4 __attribute__((ext_vector_type(4)));
typedef unsigned u32x2 __attribute__((ext_vector_type(2)));

constexpr int DM = 2048, FF = 5632, TCMAX = 32768, NCHUNK = 2;
constexpr int EVN = 6144, ODN = 7168;
constexpr float EPS = 1e-6f;
constexpr int NTHREADS = 512;

constexpr size_t SZ_WINE = (size_t)EVN * DM * 2, SZ_WOUT = (size_t)DM * DM * 2, SZ_WINO = (size_t)ODN * DM * 2;
constexpr size_t SZ_WGU = (size_t)2 * FF * DM * 2, SZ_WD = (size_t)DM * FF * 2;
constexpr size_t OFF_WINE = 0;
constexpr size_t OFF_WOUTE = OFF_WINE + SZ_WINE;
constexpr size_t OFF_WINO = OFF_WOUTE + SZ_WOUT;
constexpr size_t OFF_WOUTO = OFF_WINO + SZ_WINO;
constexpr size_t OFF_WGU = OFF_WOUTO + SZ_WOUT;
constexpr size_t OFF_WD = OFF_WGU + 2 * SZ_WGU;
constexpr size_t OFF_XN = OFF_WD + 2 * SZ_WD;
constexpr size_t OFF_PROJ = OFF_XN + (size_t)TCMAX * DM * 2;
constexpr size_t OFF_AO = OFF_PROJ + (size_t)TCMAX * ODN * 2;
constexpr size_t OFF_TMP = OFF_AO + (size_t)TCMAX * DM * 2;
constexpr size_t OFF_LSE = OFF_TMP + (size_t)TCMAX * 1024 * 2;
constexpr size_t OFF_BAR = OFF_LSE + (size_t)3 * TCMAX * 4 * 4;
constexpr size_t BAR_BYTES = 3456 * 4;
constexpr size_t OFF_SSQ = OFF_BAR + BAR_BYTES;
constexpr size_t SSQ_BYTES = (size_t)NCHUNK * 5 * TCMAX * 4;
constexpr size_t OFF_WQ = OFF_SSQ + SSQ_BYTES;
constexpr size_t WQ_BYTES = (size_t)NCHUNK * 8 * 256;
constexpr size_t ZERO_BYTES = BAR_BYTES + SSQ_BYTES + WQ_BYTES;
constexpr size_t WS_END = OFF_WQ + WQ_BYTES;

struct Params {
  const float* x_prompt; const float* x_sample; const float* attn_norm_g; const float* ev_w_in; const float* ev_lambda;
  const float* ev_subln_g; const float* ev_rpb; const float* ev_w_out; const float* od_w_in; const float* od_qk_norm_g;
  const float* od_w_out; const float* ffn_norm_g; const float* ffn_w_gate; const float* ffn_w_up; const float* ffn_w_down;
  const float* final_norm_g; float* out; char* ws;
};

__device__ __forceinline__ unsigned cvtpk(float lo, float hi) {
  unsigned r; asm volatile("v_cvt_pk_bf16_f32 %0, %1, %2" : "=v"(r) : "v"(lo), "v"(hi)); return r;
}
__device__ __forceinline__ float bflo(unsigned w) { return __uint_as_float(w << 16); }
__device__ __forceinline__ float bfhi(unsigned w) { return __uint_as_float(w & 0xffff0000u); }
__device__ __forceinline__ float wave_sum(float v) {
#pragma unroll
  for (int o = 32; o > 0; o >>= 1) v += __shfl_xor(v, o, 64);
  return v;
}
__device__ __forceinline__ int otid() { int t = threadIdx.x; asm volatile("" : "+v"(t)); return t; }
__device__ __forceinline__ int obid() { int b = blockIdx.x; asm volatile("" : "+s"(b)); return b; }
__device__ __forceinline__ int perm32(int rho) { const int n = rho >> 4, i = rho & 15; return 8 * (i >> 2) + 4 * n + (i & 3); }

__device__ __forceinline__ void convert_tile(const float* __restrict__ src, int N, int K, bf16_t* __restrict__ dst, int tk, int tn4, int mode, float* tile, const float* __restrict__ gk) {
  const int tid = otid();
#pragma unroll
  for (int i = 0; i < 8; ++i) {
    const int idx = tid + i * 512; const int r = idx >> 6, c4 = (idx & 63) * 4;
    f32x4 v = *(const f32x4*)(src + (size_t)(tk * 64 + r) * N + tn4 * 256 + c4);
    if (gk != nullptr) v *= gk[tk * 64 + r];
    float* tp = tile + (c4 >> 6) * (64 * 65) + r * 65 + (c4 & 63);
    tp[0] = v[0]; tp[1] = v[1]; tp[2] = v[2]; tp[3] = v[3];
  }
  __syncthreads();
#pragma unroll
  for (int i = 0; i < 4; ++i) {
    const int ch = tid + i * 512; const int d = ch >> 3, k8 = (ch & 7) * 8; const int sub = d >> 6, dd = d & 63;
    const int nsrc = (dd & 32) + perm32(dd & 31);
    const float* tp = tile + sub * (64 * 65) + k8 * 65 + nsrc;
    const u32x4 w = {cvtpk(tp[0], tp[65]), cvtpk(tp[2 * 65], tp[3 * 65]), cvtpk(tp[4 * 65], tp[5 * 65]), cvtpk(tp[6 * 65], tp[7 * 65])};
    const int tn = tn4 * 4 + sub;
    int row0 = tn * 64;
    if (mode) row0 = (tn >> 1) * 256 + (tn & 1) * 64 + (mode == 2 ? 128 : 0);
    *(u32x4*)(dst + (size_t)(row0 + dd) * K + tk * 64 + k8) = w;
  }
  __syncthreads();
}

__device__ __forceinline__ void convert_weights(const Params& p, float* tile) {
  constexpr int T_INE = 32 * (EVN / 256), T_OUT = 32 * (DM / 256), T_INO = 32 * (ODN / 256), T_GU = 32 * (FF / 256), T_D = (FF / 64) * (DM / 256);
  constexpr int TOTAL = T_INE + T_OUT + T_INO + T_OUT + 4 * T_GU + 2 * T_D;
  char* ws = p.ws;
  for (int L = obid(); L < TOTAL; L += gridDim.x) {
    int t = L; const float* src; bf16_t* dst; int K, N, mode = 0; const float* gk = nullptr;
    if (t < T_INE) { src = p.ev_w_in; dst = (bf16_t*)(ws + OFF_WINE); K = DM; N = EVN; gk = p.attn_norm_g; }
    else if ((t -= T_INE) < T_OUT) { src = p.ev_w_out; dst = (bf16_t*)(ws + OFF_WOUTE); K = DM; N = DM; }
    else if ((t -= T_OUT) < T_INO) { src = p.od_w_in; dst = (bf16_t*)(ws + OFF_WINO); K = DM; N = ODN; gk = p.attn_norm_g + DM; }
    else if ((t -= T_INO) < T_OUT) { src = p.od_w_out; dst = (bf16_t*)(ws + OFF_WOUTO); K = DM; N = DM; }
    else if ((t -= T_OUT) < 2 * T_GU) { const int l = t / T_GU; t -= l * T_GU; src = p.ffn_w_gate + (size_t)l * DM * FF; dst = (bf16_t*)(ws + OFF_WGU + l * SZ_WGU); K = DM; N = FF; mode = 1; gk = p.ffn_norm_g + l * DM; }
    else if ((t -= 2 * T_GU) < 2 * T_GU) { const int l = t / T_GU; t -= l * T_GU; src = p.ffn_w_up + (size_t)l * DM * FF; dst = (bf16_t*)(ws + OFF_WGU + l * SZ_WGU); K = DM; N = FF; mode = 2; gk = p.ffn_norm_g + l * DM; }
    else { t -= 2 * T_GU; const int l = t / T_D; t -= l * T_D; src = p.ffn_w_down + (size_t)l * FF * DM; dst = (bf16_t*)(ws + OFF_WD + l * SZ_WD); K = FF; N = DM; }
    const int nnt = N / 256; const int tn4 = t % nnt, tk = t / nnt;
    convert_tile(src, N, K, dst, tk, tn4, mode, tile, gk);
  }
}

template <bool OUT_F32>
__device__ __forceinline__ void rmsnorm_rows(const float* __restrict__ in, const float* __restrict__ g, bf16_t* __restrict__ outb, float* __restrict__ outf, int nrows) {
  const int tid_ = otid(); const int lane = tid_ & 63; const int gw = obid() * 8 + (tid_ >> 6), nw = gridDim.x * 8;
  for (int row = gw; row < nrows; row += nw) {
    const float* rp = in + (size_t)row * DM; f32x4 v[8]; float ss = 0.f;
#pragma unroll
    for (int i = 0; i < 8; ++i) { v[i] = *(const f32x4*)(rp + (i * 64 + lane) * 4); ss += v[i][0] * v[i][0] + v[i][1] * v[i][1] + v[i][2] * v[i][2] + v[i][3] * v[i][3]; }
    ss = wave_sum(ss); const float rs = rsqrtf(ss * (1.f / DM) + EPS);
#pragma unroll
    for (int i = 0; i < 8; ++i) {
      const f32x4 g4 = *(const f32x4*)(g + (i * 64 + lane) * 4);
      const float y0 = v[i][0] * rs * g4[0], y1 = v[i][1] * rs * g4[1], y2 = v[i][2] * rs * g4[2], y3 = v[i][3] * rs * g4[3];
      if constexpr (OUT_F32) { const f32x4 y = {y0, y1, y2, y3}; *(f32x4*)(outf + (size_t)row * DM + (i * 64 + lane) * 4) = y; }
      else { const u32x2 w = {cvtpk(y0, y1), cvtpk(y2, y3)}; *(u32x2*)(outb + (size_t)row * DM + (i * 64 + lane) * 4) = w; }
    }
  }
}

__device__ __forceinline__ void final_norm_rows(const bf16_t* __restrict__ in, const float* __restrict__ g, float* __restrict__ outf, int nrows) {
  const int tid_ = otid(); const int lane = tid_ & 63; const int gw = obid() * 8 + (tid_ >> 6), nw = gridDim.x * 8;
  for (int row = gw; row < nrows; row += nw) {
    const bf16_t* rp = in + (size_t)row * DM; u32x4 v[4]; float ss = 0.f;
#pragma unroll
    for (int i = 0; i < 4; ++i) { v[i] = *(const u32x4*)(rp + (i * 64 + lane) * 8);
#pragma unroll
      for (int k = 0; k < 4; ++k) { const float a = bflo(v[i][k]), b = bfhi(v[i][k]); ss += a * a + b * b; } }
    ss = wave_sum(ss); const float rs = rsqrtf(ss * (1.f / DM) + EPS);
#pragma unroll
    for (int i = 0; i < 4; ++i) {
      const f32x4 g0 = *(const f32x4*)(g + (i * 64 + lane) * 8), g1 = *(const f32x4*)(g + (i * 64 + lane) * 8 + 4);
      const f32x4 y0 = {bflo(v[i][0]) * rs * g0[0], bfhi(v[i][0]) * rs * g0[1], bflo(v[i][1]) * rs * g0[2], bfhi(v[i][1]) * rs * g0[3]};
      const f32x4 y1 = {bflo(v[i][2]) * rs * g1[0], bfhi(v[i][2]) * rs * g1[1], bflo(v[i][3]) * rs * g1[2], bfhi(v[i][3]) * rs * g1[3]};
      *(f32x4*)(outf + (size_t)row * DM + (i * 64 + lane) * 8) = y0; *(f32x4*)(outf + (size_t)row * DM + (i * 64 + lane) * 8 + 4) = y1;
    }
  }
}

__device__ __forceinline__ void cast_rows(const float* __restrict__ in, bf16_t* __restrict__ outb, float* __restrict__ ssq, int nrows) {
  const int tid_ = otid(); const int lane = tid_ & 63; const int gw = obid() * 8 + (tid_ >> 6), nw = gridDim.x * 8;
  for (int row = gw; row < nrows; row += nw) {
    const float* rp = in + (size_t)row * DM; float ss = 0.f;
#pragma unroll
    for (int i = 0; i < 8; ++i) {
      const f32x4 v = *(const f32x4*)(rp + (i * 64 + lane) * 4); ss += v[0] * v[0] + v[1] * v[1] + v[2] * v[2] + v[3] * v[3];
      const u32x2 w = {cvtpk(v[0], v[1]), cvtpk(v[2], v[3])}; *(u32x2*)(outb + (size_t)row * DM + (i * 64 + lane) * 4) = w;
    }
    ss = wave_sum(ss);
    if (lane == 0) ssq[row] = ss;
  }
}

constexpr int BM = 256, BK = 64, HALF = 128, HT = HALF * BK;
constexpr int GEMM_LDS = 8 * HT * 2;
__device__ __forceinline__ int lds_byte(int r, int c) {
  const int st = (r >> 4) * 2 + (c >> 5), rr = r & 15, cc = c & 31, ob = rr * 64 + cc * 2;
  return st * 1024 + (ob ^ (((ob >> 9) & 1) << 5));
}
__device__ __forceinline__ void stage_rc(int b, int& R, int& C) {
  const int st = b / 1024, sb = b % 1024, swz = sb ^ (((sb >> 9) & 1) << 5);
  R = (st >> 1) * 16 + swz / 64; C = (st & 1) * 32 + (swz % 64) / 2;
}
struct EpiArgs { bf16_t* outb; int ldc; const bf16_t* res; float* outf; const float* ssq_in; float* ssq_out; };
#define LAS __attribute__((address_space(3)))

template <int EPI>
__device__ __forceinline__ void gemm_epi(const f32x4 (&acc)[2][2][4][2], const float (&sq)[2][4], const int pm, const int pn, const int wr, const int wc, const int fr, const int fq, const EpiArgs e) {
  const int row0 = pm * BM + wr * 64 + fr, colt = wc * 32 + 8 * fq, bcol = pn * BM;
  if constexpr (EPI == 1) {
    u32x4 rv[2][4][2];
#pragma unroll
    for (int ai = 0; ai < 2; ++ai)
#pragma unroll
      for (int m = 0; m < 4; ++m)
#pragma unroll
        for (int bj = 0; bj < 2; ++bj) rv[ai][m][bj] = *(const u32x4*)(e.res + (size_t)(row0 + ai * HALF + m * 16) * DM + bcol + bj * HALF + colt);
#pragma unroll
    for (int ai = 0; ai < 2; ++ai)
#pragma unroll
      for (int m = 0; m < 4; ++m) {
        const size_t row = (size_t)(row0 + ai * HALF + m * 16);
        float ssr = 0.f;
#pragma unroll
        for (int bj = 0; bj < 2; ++bj) {
          const size_t off = row * DM + bcol + bj * HALF + colt;
          const u32x4 r = rv[ai][m][bj];
          const f32x4 r0 = {bflo(r[0]), bfhi(r[0]), bflo(r[1]), bfhi(r[1])}, r1 = {bflo(r[2]), bfhi(r[2]), bflo(r[3]), bfhi(r[3])};
          const f32x4 o0 = r0 + acc[ai][bj][m][0], o1 = r1 + acc[ai][bj][m][1];
          const u32x4 w = {cvtpk(o0[0], o0[1]), cvtpk(o0[2], o0[3]), cvtpk(o1[0], o1[1]), cvtpk(o1[2], o1[3])};
          *(u32x4*)(e.outb + off) = w;
          ssr += o0[0] * o0[0] + o0[1] * o0[1] + o0[2] * o0[2] + o0[3] * o0[3] + o1[0] * o1[0] + o1[1] * o1[1] + o1[2] * o1[2] + o1[3] * o1[3];
        }
        ssr += __shfl_xor(ssr, 16, 64); ssr += __shfl_xor(ssr, 32, 64);
        if (fq == 0) (void)__hip_atomic_fetch_add(e.ssq_out + row, ssr, __ATOMIC_RELAXED, __HIP_MEMORY_SCOPE_AGENT);
      }
    return;
  }
#pragma unroll
  for (int ai = 0; ai < 2; ++ai)
#pragma unroll
    for (int m = 0; m < 4; ++m) {
      const size_t row = (size_t)(row0 + ai * HALF + m * 16);
      const float var = sq[ai][m] * (1.f / DM) + EPS;
      const float rstd = rsqrtf(var);
      if constexpr (EPI == 0) {
#pragma unroll
        for (int bj = 0; bj < 2; ++bj) {
          const f32x4 a0 = acc[ai][bj][m][0] * rstd, a1 = acc[ai][bj][m][1] * rstd;
          const u32x4 w = {cvtpk(a0[0], a0[1]), cvtpk(a0[2], a0[3]), cvtpk(a1[0], a1[1]), cvtpk(a1[2], a1[3])};
          *(u32x4*)(e.outb + row * e.ldc + bcol + bj * HALF + colt) = w;
        }
      } else {
        float hv[8];
        const float nk = -rstd * 1.4426950408889634f;
#pragma unroll
        for (int n = 0; n < 2; ++n)
#pragma unroll
          for (int j = 0; j < 4; ++j) {
            const float ag = acc[ai][0][m][n][j], au = acc[ai][1][m][n][j];
            const float ex = __builtin_amdgcn_exp2f(ag * nk);
            hv[n * 4 + j] = (ag * au) * __builtin_amdgcn_rcpf(fmaf(ex, var, var));
          }
        const u32x4 w = {cvtpk(hv[0], hv[1]), cvtpk(hv[2], hv[3]), cvtpk(hv[4], hv[5]), cvtpk(hv[6], hv[7])};
        *(u32x4*)(e.outb + row * FF + pn * HALF + colt) = w;
      }
    }
}

__device__ __forceinline__ bool gemm_next(int i, int nM, int nN, int& pm, int& pn) {
  const int nwg = nM * nN; const int L = i * (int)gridDim.x + obid(); if (L >= nwg) return false;
  int wgid = L;
  { const int q = nwg / 8, r = nwg % 8, xcd = wgid % 8, off = wgid / 8; wgid = (xcd < r ? xcd * (q + 1) : r * (q + 1) + (xcd - r) * q) + off; }
  const int nig = 8 * nN, gid = wgid / nig, fm = gid * 8, gsz = min(nM - fm, 8);
  pm = fm + ((wgid % nig) % gsz); pn = (wgid % nig) / gsz; return true;
}

template <int EPI>
__device__ __forceinline__ void gemm_phase(const bf16_t* __restrict__ Ag, const bf16_t* __restrict__ Btg, const int M, const int N, const int K, LAS unsigned char* lds, const EpiArgs e) {
  const int tid = otid(), wid = __builtin_amdgcn_readfirstlane(tid >> 6), lane = tid & 63, wr = wid >> 2, wc = wid & 3, fr = lane & 15, fq = lane >> 4;
  const int nt = K / BK, nM = M / BM, nN = N / BM;
  constexpr int HTB = HALF * BK * 2;
  unsigned voff[2];
#pragma unroll
  for (int i = 0; i < 2; ++i) { int R, C; stage_rc(tid * 16 + i * 8192, R, C); voff[i] = (unsigned)(R * K + C) * 2u; }
  const size_t kstep = (size_t)(BK * 2);
  const size_t hstep = (size_t)HALF * K * 2;
  const size_t tstep = 2 * hstep;
  const unsigned ldsw = (unsigned)wid * 1024u;
  const int aoff = lds_byte(wr * 64 + fr, fq * 8), boff = lds_byte(wc * 32 + fr, fq * 8);
#define PG8_SA(b, h) (((b) * 2 + (h)) * HTB)
#define PG8_SB(b, h) ((4 + (b) * 2 + (h)) * HTB)
#define PG8_STAGE(bufoff, gbase) do { _Pragma("unroll") for (int _i = 0; _i < 2; ++_i) \
    __builtin_amdgcn_global_load_lds((const unsigned*)((const char*)(gbase) + voff[_i]), (LAS unsigned*)(lds + (bufoff) + ldsw + _i * 8192), 16, 0, 0); } while (0)
#define PG8_LDA(dst, b, h) do { _Pragma("unroll") for (int m = 0; m < 4; ++m) _Pragma("unroll") for (int k = 0; k < 2; ++k) dst[m][k] = *(const LAS bf16x8*)(lds + PG8_SA(b, h) + aoff + m * 2048 + k * 1024); } while (0)
#define PG8_LDB(dst, b, h) do { _Pragma("unroll") for (int n = 0; n < 2; ++n) _Pragma("unroll") for (int k = 0; k < 2; ++k) dst[n][k] = *(const LAS bf16x8*)(lds + PG8_SB(b, h) + boff + n * 2048 + k * 1024); } while (0)
#define PG8_MMA(ai, bj, At_, Bt_) do { __builtin_amdgcn_s_setprio(1); _Pragma("unroll") for (int m = 0; m < 4; ++m) _Pragma("unroll") for (int n = 0; n < 2; ++n) _Pragma("unroll") for (int k = 0; k < 2; ++k) \
    acc[ai][bj][m][n] = __builtin_amdgcn_mfma_f32_16x16x32_bf16(Bt_[n][k], At_[m][k], acc[ai][bj][m][n], 0, 0, 0); __builtin_amdgcn_s_setprio(0); } while (0)
#define PG8_WAIT_V(n) asm volatile("s_waitcnt vmcnt(" #n ")" ::: "memory")
#define PG8_WAIT_L(n) asm volatile("s_waitcnt lgkmcnt(" #n ")" ::: "memory")
#define PG8_BAR __builtin_amdgcn_s_barrier()
#define PG8_SCHED __builtin_amdgcn_sched_barrier(0)
  int cpm, cpn, npm = 0, npn = 0, ui = 0;
  if (!gemm_next(0, nM, nN, cpm, cpn)) return;
  f32x4 acc[2][2][4][2];
#pragma unroll
  for (int a = 0; a < 2; ++a)
#pragma unroll
    for (int b = 0; b < 2; ++b)
#pragma unroll
      for (int m = 0; m < 4; ++m)
#pragma unroll
        for (int n = 0; n < 2; ++n) acc[a][b][m][n] = (f32x4){0.f, 0.f, 0.f, 0.f};
  bf16x8 At[4][2], B0[2][2], B1[2][2];
  float sq[2][4] = {};
  const char* cA = (const char*)Ag + (size_t)cpm * tstep; const char* cB = (const char*)Btg + (size_t)cpn * tstep;
  PG8_STAGE(PG8_SB(0, 0), cB); PG8_STAGE(PG8_SB(0, 1), cB + hstep); PG8_STAGE(PG8_SA(0, 0), cA); PG8_STAGE(PG8_SA(0, 1), cA + hstep);
  if (wr == 1) PG8_BAR;
  PG8_WAIT_V(2); PG8_BAR;
  PG8_STAGE(PG8_SB(1, 0), cB + kstep); PG8_STAGE(PG8_SA(1, 0), cA + kstep); PG8_STAGE(PG8_SB(1, 1), cB + hstep + kstep);
  PG8_WAIT_V(6); PG8_BAR;
  for (;;) {
    const bool has_next = gemm_next(ui + 1, nM, nN, npm, npn);
    const char* nA = has_next ? (const char*)Ag + (size_t)npm * tstep : cA; const char* nB = has_next ? (const char*)Btg + (size_t)npn * tstep : cB;
    for (int t = 0; t < nt; t += 2) {
      const bool last = (t == nt - 2);
      const char* a1 = cA + (size_t)(t + 1) * kstep;
      const char* a2 = last ? nA : cA + (size_t)(t + 2) * kstep; const char* b2 = last ? nB : cB + (size_t)(t + 2) * kstep;
      const char* a3 = a2 + kstep; const char* b3 = b2 + kstep;
      if constexpr (EPI != 1) { if (last) {
        const float* sp = e.ssq_in + cpm * BM + wr * 64 + fr;
#pragma unroll
        for (int ai = 0; ai < 2; ++ai)
#pragma unroll
          for (int m = 0; m < 4; ++m) sq[ai][m] = sp[ai * HALF + m * 16];
        PG8_SCHED; } }
      PG8_LDB(B0, 0, 0); PG8_LDB(B1, 0, 1); PG8_SCHED; PG8_LDA(At, 0, 0); PG8_STAGE(PG8_SA(1, 1), a1 + hstep);
      PG8_WAIT_V(8); PG8_WAIT_L(0); PG8_BAR; PG8_MMA(0, 0, At, B0); PG8_MMA(0, 1, At, B1); PG8_BAR; PG8_SCHED;
      PG8_LDA(At, 0, 1); PG8_STAGE(PG8_SB(0, 0), b2); PG8_STAGE(PG8_SB(0, 1), b2 + hstep); PG8_STAGE(PG8_SA(0, 0), a2);
      PG8_WAIT_V(8); PG8_WAIT_L(0); PG8_BAR; PG8_MMA(1, 0, At, B0); PG8_MMA(1, 1, At, B1); PG8_BAR; PG8_SCHED;
      PG8_LDB(B0, 1, 0); PG8_LDB(B1, 1, 1); PG8_SCHED; PG8_LDA(At, 1, 0); PG8_STAGE(PG8_SA(0, 1), a2 + hstep);
      PG8_WAIT_V(8); PG8_WAIT_L(0); PG8_BAR; PG8_MMA(0, 0, At, B0); PG8_MMA(0, 1, At, B1); PG8_BAR; PG8_SCHED;
      PG8_LDA(At, 1, 1); PG8_STAGE(PG8_SB(1, 0), b3); PG8_STAGE(PG8_SB(1, 1), b3 + hstep); PG8_STAGE(PG8_SA(1, 0), a3);
      PG8_WAIT_V(8); PG8_WAIT_L(0); PG8_BAR; PG8_MMA(1, 0, At, B0); PG8_MMA(1, 1, At, B1); PG8_BAR; PG8_SCHED;
    }
    if (wr == 0) PG8_BAR;
    gemm_epi<EPI>(acc, sq, cpm, cpn, wr, wc, fr, fq, e);
    if (!has_next) break;
#pragma unroll
    for (int a = 0; a < 2; ++a)
#pragma unroll
      for (int b = 0; b < 2; ++b)
#pragma unroll
        for (int m = 0; m < 4; ++m)
#pragma unroll
          for (int n = 0; n < 2; ++n) acc[a][b][m][n] = (f32x4){0.f, 0.f, 0.f, 0.f};
    cpm = npm; cpn = npn; cA = nA; cB = nB; ++ui;
    if (wr == 1) PG8_BAR;
  }
  PG8_WAIT_V(0);
  PG8_BAR;
#undef PG8_SA
#undef PG8_SB
#undef PG8_STAGE
#undef PG8_LDA
#undef PG8_LDB
#undef PG8_MMA
#undef PG8_WAIT_V
#undef PG8_WAIT_L
#undef PG8_BAR
#undef PG8_SCHED
}

constexpr float SCALE = 0.088388347648318440f;
constexpr float THR = 8.f;
constexpr float M_INIT = -30000.f, MASKV = -1.0e9f;
constexpr int KVBLK = 64;
constexpr size_t SHM_V = KVBLK * 128 * 2, SHM_K = KVBLK * 128 * 2;
constexpr size_t ATT_TBL_OFF = 2 * SHM_V + 2 * SHM_K + 8 * 64 * 4;
#define KSWZ(row, colB) ((row) * 256 + ((colB) ^ (((row) & 7) << 4)))
#define SBAR() __builtin_amdgcn_sched_barrier(0)
__device__ __forceinline__ int crow(int r, int hi) { return (r & 3) + 8 * (r >> 2) + 4 * hi; }

__device__ __forceinline__ void partialSM(f32x16& p0, f32x16& p1, float& m_reg, float& mn, float& alpha) {
  constexpr float C = SCALE * 1.4426950408889634f;
  float pmax = p0[0];
#pragma unroll
  for (int r = 1; r < 16; ++r) pmax = fmaxf(pmax, p0[r]);
#pragma unroll
  for (int r = 0; r < 16; ++r) pmax = fmaxf(pmax, p1[r]);
  { auto rr = __builtin_amdgcn_permlane32_swap(__float_as_uint(pmax), __float_as_uint(pmax), false, false);
    pmax = fmaxf(__uint_as_float(rr[0]), __uint_as_float(rr[1])); }
  if (__builtin_expect(__all(pmax - m_reg <= THR / SCALE), 1)) { mn = m_reg; alpha = 1.f; }
  else { mn = fmaxf(m_reg, pmax); alpha = __builtin_amdgcn_exp2f((m_reg - mn) * C); m_reg = mn; }
  const float mnC = -mn * C;
#pragma unroll
  for (int r = 0; r < 16; ++r) p0[r] = fmaf(p0[r], C, mnC);
#pragma unroll
  for (int r = 0; r < 16; ++r) p1[r] = fmaf(p1[r], C, mnC);
#pragma unroll
  for (int r = 0; r < 16; ++r) p0[r] = __builtin_amdgcn_exp2f(p0[r]);
}
__device__ __forceinline__ void finishSM(f32x16& p0, f32x16& p1, float alpha, float& l_reg, bf16x8& pa0, bf16x8& pa1, bf16x8& pa2, bf16x8& pa3) {
#pragma unroll
  for (int r = 0; r < 16; ++r) p1[r] = __builtin_amdgcn_exp2f(p1[r]);
  float ps = 0;
#pragma unroll
  for (int r = 0; r < 16; ++r) ps += p0[r];
#pragma unroll
  for (int r = 0; r < 16; ++r) ps += p1[r];
  { auto rr = __builtin_amdgcn_permlane32_swap(__float_as_uint(ps), __float_as_uint(ps), false, false);
    ps = __uint_as_float(rr[0]) + __uint_as_float(rr[1]); }
  l_reg = l_reg * alpha + ps;
#define PK4(P, BASE, OUT) do { unsigned a0 = cvtpk(P[BASE + 0], P[BASE + 1]), a1 = cvtpk(P[BASE + 2], P[BASE + 3]);   \
    unsigned b0 = cvtpk(P[BASE + 4], P[BASE + 5]), b1 = cvtpk(P[BASE + 6], P[BASE + 7]);                              \
    auto r0 = __builtin_amdgcn_permlane32_swap(a0, b0, false, false); auto r1 = __builtin_amdgcn_permlane32_swap(a1, b1, false, false); \
    u32x4 w = {r0[0], r1[0], r0[1], r1[1]}; OUT = *reinterpret_cast<bf16x8*>(&w); } while (0)
  PK4(p0, 0, pa0); PK4(p0, 8, pa1); PK4(p1, 0, pa2); PK4(p1, 8, pa3);
#undef PK4
}
__device__ __forceinline__ bool partialSM_z(f32x16& p0, f32x16& p1, float& m_reg, float& mn, float& alpha) {
  constexpr float C = SCALE * 1.4426950408889634f;
  float pmax = p0[0];
#pragma unroll
  for (int r = 1; r < 16; ++r) pmax = fmaxf(pmax, p0[r]);
#pragma unroll
  for (int r = 0; r < 16; ++r) pmax = fmaxf(pmax, p1[r]);
  { auto rr = __builtin_amdgcn_permlane32_swap(__float_as_uint(pmax), __float_as_uint(pmax), false, false);
    pmax = fmaxf(__uint_as_float(rr[0]), __uint_as_float(rr[1])); }
  const bool allz = __all(pmax - m_reg < -140.f / C);
  if (allz) { alpha = 1.f; return true; }
  if (__builtin_expect(__all(pmax - m_reg <= THR / SCALE), 1)) { mn = m_reg; alpha = 1.f; }
  else { mn = fmaxf(m_reg, pmax); alpha = __builtin_amdgcn_exp2f((m_reg - mn) * C); m_reg = mn; }
  const float mnC = -mn * C;
#pragma unroll
  for (int r = 0; r < 16; ++r) p0[r] = fmaf(p0[r], C, mnC);
#pragma unroll
  for (int r = 0; r < 16; ++r) p1[r] = fmaf(p1[r], C, mnC);
#pragma unroll
  for (int r = 0; r < 16; ++r) p0[r] = __builtin_amdgcn_exp2f(p0[r]);
  return allz;
}
__device__ __forceinline__ void partialSM_fix(f32x16& p0, f32x16& p1, const float m_reg) {
  constexpr float C = SCALE * 1.4426950408889634f;
  const float mnC = -m_reg * C;
#pragma unroll
  for (int r = 0; r < 16; ++r) p0[r] = fmaf(p0[r], C, mnC);
#pragma unroll
  for (int r = 0; r < 16; ++r) p1[r] = fmaf(p1[r], C, mnC);
#pragma unroll
  for (int r = 0; r < 16; ++r) p0[r] = __builtin_amdgcn_exp2f(p0[r]);
}
__device__ __forceinline__ void finishSM_fix(f32x16& p0, f32x16& p1, bf16x8& pa0, bf16x8& pa1, bf16x8& pa2, bf16x8& pa3) {
#pragma unroll
  for (int r = 0; r < 16; ++r) p1[r] = __builtin_amdgcn_exp2f(p1[r]);
#define PK4(P, BASE, OUT) do { unsigned a0 = cvtpk(P[BASE + 0], P[BASE + 1]), a1 = cvtpk(P[BASE + 2], P[BASE + 3]);   \
    unsigned b0 = cvtpk(P[BASE + 4], P[BASE + 5]), b1 = cvtpk(P[BASE + 6], P[BASE + 7]);                              \
    auto r0 = __builtin_amdgcn_permlane32_swap(a0, b0, false, false); auto r1 = __builtin_amdgcn_permlane32_swap(a1, b1, false, false); \
    u32x4 w = {r0[0], r1[0], r0[1], r1[1]}; OUT = *reinterpret_cast<bf16x8*>(&w); } while (0)
  PK4(p0, 0, pa0); PK4(p0, 8, pa1); PK4(p1, 0, pa2); PK4(p1, 8, pa3);
#undef PK4
}
__device__ __forceinline__ void qkt(f32x16& p0, f32x16& p1, const bf16_t* Ks, const bf16x8* qr, int r32, int hi) {
  p0 = f32x16{}; p1 = f32x16{};
#pragma unroll
  for (int d0 = 0; d0 < 8; ++d0) { const int cb = (d0 * 16 + hi * 8) * 2;
    const bf16x8 b0 = *reinterpret_cast<const bf16x8*>((const char*)Ks + KSWZ(r32, cb));
    const bf16x8 b1 = *reinterpret_cast<const bf16x8*>((const char*)Ks + KSWZ(32 + r32, cb));
    p0 = __builtin_amdgcn_mfma_f32_32x32x16_bf16(b0, qr[d0], p0, 0, 0, 0);
    p1 = __builtin_amdgcn_mfma_f32_32x32x16_bf16(b1, qr[d0], p1, 0, 0, 0); }
}
__device__ __forceinline__ int v_st(int k, int c) { const int kk = (k & ~0xC) | ((k & 4) << 1) | ((k & 8) >> 1); return ((kk >> 3) * 4 + (c >> 5)) * 512 + ((kk & 7) * 32 + (c & 31)) * 2; }
__device__ __forceinline__ int v_rd_base(int lane) { return ((lane & 3) << 3) | (((lane >> 2) & 3) << 6) | (((lane >> 4) & 1) << 5) | (((lane >> 5) & 1) << 8); }
constexpr int v_rd_off(int d0, int ks, int half) { return d0 * 512 + ks * 4096 + half * 2048; }
template <int OFF> __device__ __forceinline__ s16x4 tr_read(int vb) {
  s16x4 r; asm volatile("ds_read_b64_tr_b16 %0, %1 offset:%2" : "=&v"(r) : "v"(vb), "i"(OFF) : "memory"); return r;
}
template <int D0> __device__ __forceinline__ void pv_one(f32x16& od, int vb, bf16x8 pa0, bf16x8 pa1, bf16x8 pa2, bf16x8 pa3) {
  const s16x4 l0 = tr_read<v_rd_off(D0, 0, 0)>(vb), h0 = tr_read<v_rd_off(D0, 0, 1)>(vb), l1 = tr_read<v_rd_off(D0, 1, 0)>(vb), h1 = tr_read<v_rd_off(D0, 1, 1)>(vb);
  const s16x4 l2 = tr_read<v_rd_off(D0, 2, 0)>(vb), h2 = tr_read<v_rd_off(D0, 2, 1)>(vb), l3 = tr_read<v_rd_off(D0, 3, 0)>(vb), h3 = tr_read<v_rd_off(D0, 3, 1)>(vb);
  asm volatile("s_waitcnt lgkmcnt(0)" ::: "memory"); SBAR();
#define PK(L, H) (bf16x8){L[0], L[1], L[2], L[3], H[0], H[1], H[2], H[3]}
  od = __builtin_amdgcn_mfma_f32_32x32x16_bf16(pa0, PK(l0, h0), od, 0, 0, 0);
  od = __builtin_amdgcn_mfma_f32_32x32x16_bf16(pa1, PK(l1, h1), od, 0, 0, 0);
  od = __builtin_amdgcn_mfma_f32_32x32x16_bf16(pa2, PK(l2, h2), od, 0, 0, 0);
  od = __builtin_amdgcn_mfma_f32_32x32x16_bf16(pa3, PK(l3, h3), od, 0, 0, 0);
#undef PK
}
__device__ __forceinline__ void pv_d0(f32x16* o, int vb, bf16x8 pa0, bf16x8 pa1, bf16x8 pa2, bf16x8 pa3) {
  pv_one<0>(o[0], vb, pa0, pa1, pa2, pa3); pv_one<1>(o[1], vb, pa0, pa1, pa2, pa3); pv_one<2>(o[2], vb, pa0, pa1, pa2, pa3); pv_one<3>(o[3], vb, pa0, pa1, pa2, pa3);
}

struct AttnArgs {
  const bf16_t* Q; const bf16_t* K; const bf16_t* V; bf16_t* O; float* lse;
  int ldq, ldk, ldo, ldl;
  int q0, kt0, nt;
  int lL, ldil;
  float nsl;
  int rows;
  const float* qg = nullptr;
};

template <int MODE>
__device__ __forceinline__ void apply_bias(f32x16& p0, f32x16& p1, const int kt, const int rho_q, const int hi, const float nsl, const int lL,
                                           const float* tbl, const int qrow_g, const int qc, const int r0, const int c0) {
  if constexpr (MODE == 1 || MODE == 2) {
    const float fd = (float)(kt - rho_q + 4 * hi);
    bool tile_ok = true;
    if constexpr (MODE == 2) tile_ok = ((kt >> lL) == (rho_q >> lL));
#pragma unroll
    for (int r = 0; r < 16; ++r) {
      const float c = (float)((r & 3) + 8 * (r >> 2));
      const float d0 = fabsf(fd + c), d1 = fabsf(fd + (c + 32.f));
      float v0 = fmaf(nsl, d0, p0[r]), v1 = fmaf(nsl, d1, p1[r]);
      if constexpr (MODE == 2) { v0 = (tile_ok && d0 <= 64.f) ? v0 : MASKV; v1 = (tile_ok && d1 <= 64.f) ? v1 : MASKV; }
      p0[r] = v0; p1[r] = v1;
    }
  } else if constexpr (MODE == 3) {
    const int krow = kt >> 6; const bool rowok = (krow >= r0) && (krow < r0 + 8);
    int dr = krow - lL + 7; dr = min(max(dr, 0), 14);
    const float* trow = tbl + dr * 128 + qrow_g;
    const unsigned mlo = rowok ? (unsigned)qc : 0u, mhi = rowok ? (unsigned)c0 : 0u;
#pragma unroll
    for (int r = 0; r < 16; ++r) {
      const int cc = (r & 3) + 8 * (r >> 2);
      const float b0 = trow[cc], b1 = trow[cc + 32];
      p0[r] = (mlo & (1u << cc)) ? p0[r] + b0 : MASKV; p1[r] = (mhi & (1u << cc)) ? p1[r] + b1 : MASKV;
    }
  }
}

template <int MODE, int FIX = 0>
__device__ __forceinline__ void attn_body(const AttnArgs a, char* lds, float& m_io, float& l_io, unsigned long long& zmask) {
  const int tid = otid(), wid = __builtin_amdgcn_readfirstlane(tid >> 6), lane = tid & 63, r32 = lane & 31, hi = lane >> 5;
  bf16_t* V_lds = (bf16_t*)lds; bf16_t* K_lds = (bf16_t*)(lds + 2 * SHM_V);
  float* wsl = (float*)(lds + 2 * SHM_V + 2 * SHM_K) + wid * 64; float* li_l = wsl; float* al_l = wsl + 32;
  const float* tbl = (const float*)(lds + ATT_TBL_OFF);
  float m_reg = FIX ? m_io : M_INIT, l_reg = FIX ? l_io : 0.f; f32x16 o[4] = {}; bf16x8 qr[8];
  const int Lm = (1 << a.lL) - 1, lL = a.lL, ldil = a.ldil;
#define TOK(rho) ((((rho) & Lm) << ldil) + ((rho) >> lL))
  const int rho_q = a.q0 + wid * 32 + r32;
  const bf16_t* Qw = a.Q + (long)TOK(rho_q) * a.ldq + hi * 8;
#pragma unroll
  for (int d0 = 0; d0 < 8; ++d0) qr[d0] = *reinterpret_cast<const bf16x8*>(Qw + d0 * 16);
  if constexpr (MODE == 0) {
    float ssq = 0.f;
#pragma unroll
    for (int d0 = 0; d0 < 8; ++d0) { const u32x4 w = *reinterpret_cast<const u32x4*>(&qr[d0]);
#pragma unroll
      for (int k = 0; k < 4; ++k) { const float x0 = bflo(w[k]), x1 = bfhi(w[k]); ssq += x0 * x0 + x1 * x1; } }
    { auto rr = __builtin_amdgcn_permlane32_swap(__float_as_uint(ssq), __float_as_uint(ssq), false, false);
      ssq = __uint_as_float(rr[0]) + __uint_as_float(rr[1]); }
    const float rs = rsqrtf(ssq * (1.f / 128.f) + EPS);
    const int pos = rho_q & (a.rows - 1);
    const float prow = (float)(pos >> 6), pcol = (float)(pos & 63);
#pragma unroll
    for (int d0 = 0; d0 < 8; ++d0) {
      const float pp = (d0 < 4) ? prow : pcol;
      u32x4 w = *reinterpret_cast<const u32x4*>(&qr[d0]);
      const float* gp = a.qg + d0 * 16 + hi * 8;
      const f32x4 g0 = *(const f32x4*)gp, g1 = *(const f32x4*)(gp + 4);
      const float gg[8] = {g0[0], g0[1], g0[2], g0[3], g1[0], g1[1], g1[2], g1[3]};
#pragma unroll
      for (int k = 0; k < 4; ++k) {
        const float fr = exp2f(-(float)((d0 & 3) * 8 + hi * 4 + k) * (13.287712379549449f / 32.f)) * 0.15915494309189535f;
        const float rev = pp * fr;
        const float sn = __builtin_amdgcn_sinf(rev), cs = __builtin_amdgcn_cosf(rev);
        const float x0 = bflo(w[k]) * rs * gg[2 * k], x1 = bfhi(w[k]) * rs * gg[2 * k + 1];
        w[k] = cvtpk(x0 * cs - x1 * sn, x0 * sn + x1 * cs);
      }
      qr[d0] = *reinterpret_cast<bf16x8*>(&w);
    }
  }
  int qrow_g = 0, qc = 0, r0 = 0, c0 = 0, lLb = lL;
  if constexpr (MODE == 3) {
    const int qrg = (a.q0 + wid * 32) >> 6, qcol = ((wid & 1) << 5) + r32;
    r0 = min(max(qrg - 4, 0), a.rows - 8);
    const int cw = min(max(qcol - 8, 0), 48);
    const unsigned long long cm = (0xffffull << cw) >> (4 * hi);
    qc = (int)(unsigned)cm; c0 = (int)(unsigned)(cm >> 32);
    qrow_g = 63 - qcol + 4 * hi; lLb = qrg;
  }
  const float nsl = a.nsl;
  const int sr = tid >> 4, sc = (tid & 15) * 8, vst0 = v_st(sr, sc), vst1 = v_st(32 + sr, sc);
  const int vb0 = (int)(uintptr_t)V_lds + v_rd_base(lane);
  const char* Kp = (const char*)a.K; const char* Vp = (const char*)a.V; const int ldk = a.ldk;
  bf16x8 vs0, vs1, ks0, ks1;
#define SLOAD(k0) do { const unsigned t0_ = (unsigned)(TOK((k0) + sr) * ldk + sc) * 2u, t1_ = (unsigned)(TOK((k0) + 32 + sr) * ldk + sc) * 2u; \
    vs0 = *reinterpret_cast<const bf16x8*>(Vp + t0_); vs1 = *reinterpret_cast<const bf16x8*>(Vp + t1_); \
    ks0 = *reinterpret_cast<const bf16x8*>(Kp + t0_); ks1 = *reinterpret_cast<const bf16x8*>(Kp + t1_); } while (0)
#define SWRITE(b, V0, V1, K0, K1) do { *(bf16x8*)((char*)V_lds + (b) * SHM_V + vst0) = V0; \
    *(bf16x8*)((char*)V_lds + (b) * SHM_V + vst1) = V1; const int kc_ = sc * 2; \
    *(bf16x8*)((char*)K_lds + (b) * SHM_K + KSWZ(sr, kc_)) = K0; \
    *(bf16x8*)((char*)K_lds + (b) * SHM_K + KSWZ(32 + sr, kc_)) = K1; } while (0)
#define SWAIT() asm volatile("s_waitcnt vmcnt(0)" ::: "memory")
#define RESC(al) do { if (__any((al) < 1.f)) { if (hi == 0) al_l[r32] = (al); asm volatile("s_waitcnt lgkmcnt(0)" ::: "memory"); \
    for (int d = 0; d < 4; ++d) for (int r = 0; r < 16; ++r) o[d][r] *= al_l[crow(r, hi)]; } } while (0)
#define BIAS(P0, P1, kt) apply_bias<MODE>(P0, P1, (kt), rho_q, hi, nsl, lLb, tbl, qrow_g, qc, r0, c0)
#define PSM(P0, P1, MN, AL) do { if constexpr (FIX) { partialSM_fix(P0, P1, m_reg); AL = 1.f; } else partialSM(P0, P1, m_reg, MN, AL); } while (0)
#define FSM(P0, P1, AL) do { if constexpr (FIX) finishSM_fix(P0, P1, pa0, pa1, pa2, pa3); else finishSM(P0, P1, AL, l_reg, pa0, pa1, pa2, pa3); } while (0)
#define RESCX(AL) do { if constexpr (!FIX) RESC(AL); } while (0)
  f32x16 pA0, pA1, pB0, pB1; float mnA, mnB, alA, alB; bf16x8 pa0, pa1, pa2, pa3; const int NT = a.nt; const int kt0 = a.kt0;
  const int qw_u = __builtin_amdgcn_readfirstlane(a.q0 + wid * 32), r0_u = __builtin_amdgcn_readfirstlane(r0);
  const int d0t = a.q0 >> 6;
#define KT(j) ((MODE == 1 && !FIX) ? 64 * ((j) < 4 ? d0t + (j) : ((j) - 4 < d0t ? (j) - 4 : (j))) : kt0 + (j) * KVBLK)
#define ACT(j, kt) ((MODE == 0) ? true : (MODE == 1) ? true : (MODE == 2) ? ((((kt) >> lL) == (qw_u >> lL)) && ((kt) <= qw_u + 95) && ((kt) + 127 >= qw_u)) : ((((kt) >> 6) >= r0_u) && (((kt) >> 6) < r0_u + 8)))
#define PSMZ(P0, P1, MN, AL, ACTV, J) do { if constexpr (MODE == 1 && !FIX) { if (partialSM_z(P0, P1, m_reg, MN, AL)) { zmask |= 1ull << ((J) >> 6); ACTV = false; } }     else PSM(P0, P1, MN, AL); } while (0)
  if constexpr (MODE == 1 && !FIX) zmask = 0ull;
  bool actA, actB;
  { const int k_ = KT(0); SLOAD(k_); } SWAIT(); SWRITE(0, vs0, vs1, ks0, ks1); __syncthreads();
  { const int k_ = KT(0); actA = ACT(0, k_);
    if (actA) { qkt(pA0, pA1, K_lds, qr, r32, hi); BIAS(pA0, pA1, k_); PSMZ(pA0, pA1, mnA, alA, actA, k_); } else alA = 1.f; }
  { const int k_ = KT(1); SLOAD(k_); }
  SWAIT(); SWRITE(1, vs0, vs1, ks0, ks1); __syncthreads();
  for (int j = 1; j + 1 < NT; j += 2) {
    const int kj = KT(j), kj1 = KT(j + 1), kj2 = KT(j + 2);
    actB = ACT(j, kj);
    SBAR(); if (actB) qkt(pB0, pB1, (bf16_t*)((char*)K_lds + SHM_K), qr, r32, hi);
    if (actA) FSM(pA0, pA1, alA); SBAR();
    SLOAD(kj1); SBAR();
    if (actA) pv_d0(o, vb0, pa0, pa1, pa2, pa3);
    if (actB) { BIAS(pB0, pB1, kj); PSMZ(pB0, pB1, mnB, alB, actB, kj); } else alB = 1.f;
    __syncthreads(); SWAIT(); SWRITE(0, vs0, vs1, ks0, ks1);
    RESCX(alB); __syncthreads();
    actA = ACT(j + 1, kj1);
    SBAR(); if (actA) qkt(pA0, pA1, K_lds, qr, r32, hi);
    if (actB) FSM(pB0, pB1, alB); SBAR();
    SLOAD(kj2); SBAR();
    if (actB) pv_d0(o, vb0 + (int)SHM_V, pa0, pa1, pa2, pa3);
    if (actA) { BIAS(pA0, pA1, kj1); PSMZ(pA0, pA1, mnA, alA, actA, kj1); } else alA = 1.f;
    __syncthreads(); SWAIT(); SWRITE(1, vs0, vs1, ks0, ks1);
    RESCX(alA); __syncthreads();
  }
  { const int kl = KT(NT - 1);
    actB = ACT(NT - 1, kl);
    SBAR(); if (actB) qkt(pB0, pB1, (bf16_t*)((char*)K_lds + SHM_K), qr, r32, hi);
    if (actA) FSM(pA0, pA1, alA); SBAR();
    if (actA) pv_d0(o, vb0, pa0, pa1, pa2, pa3);
    if (actB) { BIAS(pB0, pB1, kl); PSMZ(pB0, pB1, mnB, alB, actB, kl); } else alB = 1.f; }
  __syncthreads(); RESCX(alB);
  if (actB) { FSM(pB0, pB1, alB); SBAR();
    pv_d0(o, vb0 + (int)SHM_V, pa0, pa1, pa2, pa3); }
#undef KT
#undef PSMZ
#undef ACT
  if (hi == 0) li_l[r32] = l_reg; asm volatile("s_waitcnt lgkmcnt(0)" ::: "memory");
#pragma unroll
  for (int r = 0; r < 16; ++r) {
    const int orow = crow(r, hi); const float rli = __builtin_amdgcn_rcpf(li_l[orow]);
    bf16_t* Ow = a.O + (long)TOK(a.q0 + wid * 32 + orow) * a.ldo + r32;
#pragma unroll
    for (int d0 = 0; d0 < 4; ++d0) Ow[d0 * 32] = (bf16_t)(cvtpk(o[d0][r] * rli, 0.f) & 0xffffu);
  }
  if (a.lse != nullptr && hi == 0) a.lse[(long)TOK(rho_q) * a.ldl] = m_reg * SCALE + __logf(l_reg);
  if constexpr (!FIX) { m_io = m_reg; l_io = l_reg; }
  if constexpr (MODE == 1 && !FIX) {
    asm volatile("" ::: "memory");
    if (lane == 0) { ((unsigned*)wsl)[0] = (unsigned)zmask; ((unsigned*)wsl)[1] = (unsigned)(zmask >> 32); }
  }
  __syncthreads();
  if constexpr (MODE == 1 && !FIX) {
    unsigned zl = ~0u, zh = ~0u;
#pragma unroll
    for (int w = 0; w < 8; ++w) { const unsigned* q = (const unsigned*)((const float*)(lds + 2 * SHM_V + 2 * SHM_K) + w * 64); zl &= q[0]; zh &= q[1]; }
    zmask = ((unsigned long long)(unsigned)__builtin_amdgcn_readfirstlane((int)zh) << 32) | (unsigned)__builtin_amdgcn_readfirstlane((int)zl);
  }
#undef TOK
#undef SLOAD
#undef SWRITE
#undef SWAIT
#undef RESC
#undef BIAS
#undef PSM
#undef FSM
#undef RESCX
}

__device__ __forceinline__ int xcd_remap(int L, int n) { return (L & 7) * (n >> 3) + (L >> 3); }

__device__ __forceinline__ void attn_even(const Params& p, int S, int lS, int tc, int ci, char* lds) {
  char* ws = p.ws; const bf16_t* proj = (const bf16_t*)(ws + OFF_PROJ); bf16_t* tmp = (bf16_t*)(ws + OFF_TMP); bf16_t* ao = (bf16_t*)(ws + OFF_AO);
  bf16_t* tmp2 = (bf16_t*)(ws + OFF_PROJ) + (size_t)tc * EVN;
  const int nseq = tc / S, nqb = S / 256, lq = lS - 8;
  const int n1 = nseq * 4 * nqb;
  const int wid_ = otid() >> 6, lane_ = otid() & 63;
  const float* lv = p.ev_lambda;
  float s1 = lv[lane_] * lv[128 + lane_] + lv[64 + lane_] * lv[192 + lane_];
  float s2 = lv[256 + lane_] * lv[384 + lane_] + lv[320 + lane_] * lv[448 + lane_];
  s1 = wave_sum(s1); s2 = wave_sum(s2);
  const float lam = __expf(s1) - __expf(s2) + 0.2f;
  const f32x4 g4 = *(const f32x4*)(p.ev_subln_g + lane_ * 4);
  for (int L = obid(); L < n1; L += gridDim.x) {
    const int u = xcd_remap(L, n1); const int qb = u & (nqb - 1), h = (u >> lq) & 3, b = u >> (lq + 2);
    const bf16_t* base = proj + (size_t)b * S * EVN;
    float m_s = 0.f, l_s = 1.f; unsigned long long zm = 0ull;
#pragma unroll
    for (int c = 0; c < 2; ++c) {
      AttnArgs a;
      a.Q = base + h * 256 + c * 128; a.K = base + 1024 + h * 256 + c * 128; a.V = base + 2048 + h * 256;
      a.O = (c == 0 ? tmp : tmp2) + (size_t)b * S * 1024 + h * 256; a.lse = nullptr;
      a.ldq = EVN; a.ldk = EVN; a.ldo = 1024; a.ldl = 0; a.q0 = qb * 256; a.kt0 = 0; a.nt = S / 64; a.lL = lS; a.ldil = 0;
      a.nsl = -exp2f(-2.f * (float)(h + 1)) / SCALE; a.rows = 0;
      attn_body<1, 0>(a, lds, m_s, l_s, zm);
      a.V += 128; a.O += 128;
      {
        const int ntt = S / 64;
        unsigned long long nz = ~zm; if (ntt < 64) nz &= ((1ull << ntt) - 1ull);
        int t_lo = __builtin_ctzll(nz), t_hi = 64 - __builtin_clzll(nz);
        if ((t_hi - t_lo) & 1) { if (t_hi < ntt) ++t_hi; else --t_lo; }
        a.kt0 = t_lo * 64; a.nt = t_hi - t_lo;
      }
      attn_body<1, 1>(a, lds, m_s, l_s, zm);
    }
    asm volatile("s_waitcnt vmcnt(0)" ::: "memory");
    {
      const size_t tok0 = (size_t)b * S + qb * 256 + wid_ * 32;
#pragma unroll 1
      for (int i = 0; i < 32; i += 4) {
        u32x2 xa[4], xb[4];
#pragma unroll
        for (int k = 0; k < 4; ++k) { const size_t off = (tok0 + i + k) * 1024 + h * 256 + lane_ * 4; xa[k] = *(const u32x2*)(tmp + off); xb[k] = *(const u32x2*)(tmp2 + off); }
#pragma unroll
        for (int k = 0; k < 4; ++k) {
          const float o0 = bflo(xa[k][0]) - lam * bflo(xb[k][0]), o1 = bfhi(xa[k][0]) - lam * bfhi(xb[k][0]), o2 = bflo(xa[k][1]) - lam * bflo(xb[k][1]), o3 = bfhi(xa[k][1]) - lam * bfhi(xb[k][1]);
          float ss = o0 * o0 + o1 * o1 + o2 * o2 + o3 * o3; ss = wave_sum(ss);
          const float rs = rsqrtf(ss * (1.f / 256.f) + EPS) * 0.8f;
          const u32x2 wv = {cvtpk(o0 * rs * g4[0], o1 * rs * g4[1]), cvtpk(o2 * rs * g4[2], o3 * rs * g4[3])};
          *(u32x2*)(ao + (tok0 + i + k) * DM + h * 256 + lane_ * 4) = wv;
        }
      }
    }
  }
  const int n2 = nseq * 8 * nqb; const int rows = S / 64;
  float* tbl = (float*)(lds + ATT_TBL_OFF);
  const int grp = obid() & 7, per = n2 >> 3;
  unsigned* wq = (unsigned*)(ws + OFF_WQ) + (size_t)(ci * 8 + grp) * 64;
  volatile unsigned* ubx = (volatile unsigned*)(lds + ATT_TBL_OFF + 15 * 128 * 4);
  for (;;) {
    if (otid() == 0) *ubx = __hip_atomic_fetch_add(wq, 1u, __ATOMIC_RELAXED, __HIP_MEMORY_SCOPE_AGENT);
    __syncthreads();
    const int kq = __builtin_amdgcn_readfirstlane((int)*ubx);
    if (kq >= per) break;
    const int u = grp * per + kq; const int qb = u & (nqb - 1), hd = (u >> lq) & 7, b = u >> (lq + 3);
    for (int i = otid(); i < 15 * 31; i += NTHREADS) { const int dr = i / 31, dc = i - dr * 31; tbl[dr * 128 + 48 + dc] = p.ev_rpb[hd * (15 * 31) + i] * (1.f / SCALE); }
    const bf16_t* base = proj + (size_t)b * S * EVN;
    const int R = qb * 4;
    int t0 = min(max(R - 4, 0), rows - 8), t1 = min(max(R - 1, 0), rows - 8) + 8;
    if ((t1 - t0) & 1) { if (t1 < rows) ++t1; else --t0; }
    AttnArgs a;
    a.Q = base + 3072 + hd * 128; a.K = base + 4096 + hd * 128; a.V = base + 5120 + hd * 128;
    a.O = ao + (size_t)b * S * DM + 1024 + hd * 128; a.lse = nullptr;
    a.ldq = EVN; a.ldk = EVN; a.ldo = DM; a.ldl = 0; a.q0 = qb * 256; a.kt0 = t0 * 64; a.nt = t1 - t0; a.lL = lS; a.ldil = 0;
    a.nsl = 0.f; a.rows = rows;
    { float ms_, ls_; unsigned long long zm_ = 0ull; attn_body<3>(a, lds, ms_, ls_, zm_); }
  }
}

__device__ __forceinline__ void attn_odd(const Params& p, int S, int lS, int tc, char* lds) {
  char* ws = p.ws; bf16_t* proj = (bf16_t*)(ws + OFF_PROJ); bf16_t* ao = (bf16_t*)(ws + OFF_AO);
  float* lseb = (float*)(ws + OFF_LSE);
  const int nseq = tc / S, nqb = S / 256;
  const int n1 = nseq * 12 * nqb;
  for (int L = obid(); L < n1; L += gridDim.x) {
    const int u = xcd_remap(L, n1); const int qb = u % nqb, hq = (u / nqb) % 12, b = u / (nqb * 12);
    const int kvh = hq / 3;
    const bf16_t* base = proj + (size_t)b * S * ODN;
    AttnArgs a;
    a.Q = base + 4608 + hq * 128; a.K = base + 6144 + kvh * 128; a.V = base + 6656 + kvh * 128;
    a.O = ao + (size_t)b * S * DM + 512 + hq * 128; a.lse = nullptr;
    a.ldq = ODN; a.ldk = ODN; a.ldo = DM; a.ldl = 0; a.q0 = qb * 256; a.kt0 = 0; a.nt = S / 64; a.lL = lS; a.ldil = 0; a.nsl = 0.f; a.rows = S; a.qg = p.od_qk_norm_g;
    { float ms_, ls_; unsigned long long zm_ = 0ull; attn_body<0>(a, lds, ms_, ls_, zm_); }
  }
  for (int L = obid(); L < n1; L += gridDim.x) {
    const int u = xcd_remap(L, n1); const int qb = u % nqb, gj = (u / nqb) % 12, b = u / (nqb * 12);
    const int g = gj >> 2, j = gj & 3;
    bf16_t* base = proj + (size_t)b * S * ODN;
    const int q0 = qb * 256;
    int k0 = max(q0 - 64, 0), k1 = min(q0 + 320, S);
    if (((k1 - k0) >> 6) & 1) { if (k1 + 64 <= S) k1 += 64; else k0 -= 64; }
    AttnArgs a;
    a.Q = base + g * 512 + j * 128; a.K = base + 1536 + g * 512 + j * 128; a.V = base + 3072 + g * 512 + j * 128;
    a.O = base + g * 512 + j * 128; a.lse = lseb + (size_t)g * tc * 4 + (size_t)b * S * 4 + j;
    a.ldq = ODN; a.ldk = ODN; a.ldo = ODN; a.ldl = 4; a.q0 = q0; a.kt0 = k0; a.nt = (k1 - k0) >> 6; a.ldil = 2 * g; a.lL = lS - 2 * g;
    a.nsl = -exp2f(-8.f * (float)(gj + 1) / 12.f) * (float)(1 << (2 * g)) / SCALE; a.rows = 0;
    { float ms_, ls_; unsigned long long zm_ = 0ull; attn_body<2>(a, lds, ms_, ls_, zm_); }
  }
}

__device__ __forceinline__ void combine_diff(const Params& p, int tc) {
  char* ws = p.ws; const bf16_t* t1 = (const bf16_t*)(ws + OFF_TMP); const bf16_t* t2 = (const bf16_t*)(ws + OFF_PROJ) + (size_t)tc * EVN; bf16_t* ao = (bf16_t*)(ws + OFF_AO);
  const int tid_ = otid(); const int lane = tid_ & 63; const int gw = obid() * 8 + (tid_ >> 6), nw = gridDim.x * 8;
  const float* lv = p.ev_lambda;
  float s1 = lv[lane] * lv[128 + lane] + lv[64 + lane] * lv[192 + lane];
  float s2 = lv[256 + lane] * lv[384 + lane] + lv[320 + lane] * lv[448 + lane];
  s1 = wave_sum(s1); s2 = wave_sum(s2);
  const float lam = __expf(s1) - __expf(s2) + 0.2f;
  const f32x4 g4 = *(const f32x4*)(p.ev_subln_g + lane * 4);
  for (int tok = gw; tok < tc; tok += nw) {
    u32x2 a[4], b[4];
#pragma unroll
    for (int h = 0; h < 4; ++h) { const size_t off = (size_t)tok * 1024 + h * 256 + lane * 4; a[h] = *(const u32x2*)(t1 + off); b[h] = *(const u32x2*)(t2 + off); }
#pragma unroll
    for (int h = 0; h < 4; ++h) {
      const float o0 = bflo(a[h][0]) - lam * bflo(b[h][0]), o1 = bfhi(a[h][0]) - lam * bfhi(b[h][0]), o2 = bflo(a[h][1]) - lam * bflo(b[h][1]), o3 = bfhi(a[h][1]) - lam * bfhi(b[h][1]);
      float ss = o0 * o0 + o1 * o1 + o2 * o2 + o3 * o3; ss = wave_sum(ss);
      const float rs = rsqrtf(ss * (1.f / 256.f) + EPS) * 0.8f;
      const u32x2 wv = {cvtpk(o0 * rs * g4[0], o1 * rs * g4[1]), cvtpk(o2 * rs * g4[2], o3 * rs * g4[3])};
      *(u32x2*)(ao + (size_t)tok * DM + h * 256 + lane * 4) = wv;
    }
  }
}
__device__ __forceinline__ void combine_dil(const Params& p, int tc) {
  char* ws = p.ws; const bf16_t* proj = (const bf16_t*)(ws + OFF_PROJ); const float* lseb = (const float*)(ws + OFF_LSE); bf16_t* ao = (bf16_t*)(ws + OFF_AO);
  const int tid_ = otid(); const int lane = tid_ & 63; const int gw = obid() * 8 + (tid_ >> 6), nw = gridDim.x * 8;
  const int j = lane >> 4;
  for (int tok = gw; tok < tc; tok += nw) {
    const float l0 = lseb[(size_t)tok * 4 + j], l1 = lseb[(size_t)tc * 4 + (size_t)tok * 4 + j], l2 = lseb[(size_t)2 * tc * 4 + (size_t)tok * 4 + j];
    const float mx = fmaxf(l0, fmaxf(l1, l2)); const float e0 = __expf(l0 - mx), e1 = __expf(l1 - mx), e2 = __expf(l2 - mx);
    const float inv = 1.f / (e0 + e1 + e2); const float a0 = e0 * inv, a1 = e1 * inv, a2 = e2 * inv;
    const size_t off = (size_t)tok * ODN + lane * 8;
    const u32x4 x0 = *(const u32x4*)(proj + off), x1 = *(const u32x4*)(proj + off + 512), x2 = *(const u32x4*)(proj + off + 1024);
    u32x4 w;
#pragma unroll
    for (int i = 0; i < 4; ++i) {
      const float lo = a0 * bflo(x0[i]) + a1 * bflo(x1[i]) + a2 * bflo(x2[i]);
      const float hi = a0 * bfhi(x0[i]) + a1 * bfhi(x1[i]) + a2 * bfhi(x2[i]);
      w[i] = cvtpk(lo, hi);
    }
    *(u32x4*)(ao + (size_t)tok * DM + lane * 8) = w;
  }
}
__device__ __forceinline__ void rope_pass(const Params& p, int S, int tc) {
  bf16_t* proj = (bf16_t*)(p.ws + OFF_PROJ);
  const int tid_ = otid(); const int lane = tid_ & 63; const int gw = obid() * 8 + (tid_ >> 6), nw = gridDim.x * 8;
  const float gk0 = p.od_qk_norm_g[128 + 2 * lane], gk1 = p.od_qk_norm_g[128 + 2 * lane + 1];
  const float freq = exp2f(-(float)(lane & 31) * (13.287712379549449f / 32.f)) * 0.15915494309189535f;
  for (int tok = gw; tok < tc; tok += 2 * nw) {
    const int tok2 = (tok + nw < tc) ? tok + nw : tok;
    unsigned* ptr = (unsigned*)(proj + (size_t)tok * ODN + 6144) + lane;
    unsigned* ptr2 = (unsigned*)(proj + (size_t)tok2 * ODN + 6144) + lane;
    unsigned x[4], y[4];
#pragma unroll
    for (int hh = 0; hh < 4; ++hh) { x[hh] = ptr[hh * 64]; y[hh] = ptr2[hh * 64]; }
#pragma unroll
    for (int t = 0; t < 2; ++t) {
      const int pos = (t == 0 ? tok : tok2) & (S - 1);
      const float pp = (float)((lane < 32) ? (pos >> 6) : (pos & 63));
      const float rev = pp * freq;
      const float sn = __builtin_amdgcn_sinf(rev), cs = __builtin_amdgcn_cosf(rev);
      if (t == 1 && tok2 == tok) break;
#pragma unroll
      for (int hh = 0; hh < 4; ++hh) {
        const unsigned xv = (t == 0) ? x[hh] : y[hh];
        const float x0 = bflo(xv), x1 = bfhi(xv);
        float ss = x0 * x0 + x1 * x1; ss = wave_sum(ss);
        const float rs = rsqrtf(ss * (1.f / 128.f) + EPS);
        const float y0 = x0 * rs * gk0, y1 = x1 * rs * gk1;
        (t == 0 ? ptr : ptr2)[hh * 64] = cvtpk(y0 * cs - y1 * sn, y0 * sn + y1 * cs);
      }
    }
  }
}

#define XB_TMO      128
#define XB_XCNT(j)  (256  + 64 * (j))
#define XB_XSUB(j)  (1280 + 64 * (j))
#define XB_XGEN(j)  (2304 + 64 * (j))
#define XB_TOP      3328
#define XB_TOPGEN   3392
#define XB_SPIN_CAP (1u << 22)
__device__ __forceinline__ unsigned xb_ld(unsigned* p)              { return __hip_atomic_load(p, __ATOMIC_RELAXED, __HIP_MEMORY_SCOPE_AGENT); }
__device__ __forceinline__ unsigned xb_add(unsigned* p, unsigned v) { return __hip_atomic_fetch_add(p, v, __ATOMIC_RELAXED, __HIP_MEMORY_SCOPE_AGENT); }
__device__ __forceinline__ unsigned xb_xcc_id() { return (unsigned)__builtin_amdgcn_s_getreg((3 << 11) | 20) & 0xFu; }
#define XB_SPIN(cond, bar) do { unsigned _sp = 0; while (cond) { __builtin_amdgcn_s_sleep(1); \
    if ((++_sp & 255u) == 0u) { if (xb_ld(&(bar)[XB_TMO])) break; if (_sp > XB_SPIN_CAP) { atomicAdd(&(bar)[XB_TMO], 1u); break; } } } } while (0)
struct XcdBarrier { unsigned* bar; unsigned x; volatile LAS unsigned* st; };
__device__ __forceinline__ XcdBarrier xcd_barrier_post(unsigned* bar, volatile LAS unsigned* st) {
  XcdBarrier b; b.bar = bar; b.x = xb_xcc_id(); b.st = st;
  if (threadIdx.x == 0) (void)xb_add(&bar[XB_XCNT(b.x)], 1u);
  return b;
}
__device__ __forceinline__ void xcd_barrier_complete(unsigned* bar, unsigned x, unsigned& nloc, unsigned& nx) {
  const unsigned G = gridDim.x * gridDim.y * gridDim.z;
  unsigned sum, cnt, mine, sp = 0u;
  for (;;) {
    sum = 0u; cnt = 0u; mine = 0u;
#pragma unroll
    for (unsigned j = 0; j < 16; ++j) { const unsigned c = xb_ld(&bar[XB_XCNT(j)]); sum += c; cnt += (c > 0u) ? 1u : 0u; mine = (j == x) ? c : mine; }
    if (sum == G) break;
    __builtin_amdgcn_s_sleep(1);
    if ((++sp & 255u) == 0u) { if (xb_ld(&bar[XB_TMO])) break; if (sp > XB_SPIN_CAP) { atomicAdd(&bar[XB_TMO], 1u); break; } }
  }
  nloc = mine > 0u ? mine : 1u; nx = cnt > 0u ? cnt : 1u;
}
__device__ __forceinline__ void xcd_barrier(const XcdBarrier& b) {
  asm volatile("s_waitcnt vmcnt(0)" ::: "memory");
  __syncthreads();
  if (threadIdx.x == 0) {
    unsigned* bar = b.bar;
    __builtin_amdgcn_s_waitcnt(0);
    unsigned nloc = b.st[0], nx = b.st[1];
    if (nloc == 0u) { xcd_barrier_complete(bar, b.x, nloc, nx); b.st[0] = nloc; b.st[1] = nx; }
    const unsigned old = xb_add(&bar[XB_XSUB(b.x)], 1u);
    const unsigned gen = old / nloc;
    if (old + 1u == (gen + 1u) * nloc) {
      __builtin_amdgcn_fence(__ATOMIC_RELEASE, "agent");
      asm volatile("s_waitcnt vmcnt(0)" ::: "memory");
      const unsigned og = xb_add(&bar[XB_TOP], 1u);
      const unsigned tg = og / nx;
      if (og + 1u == (tg + 1u) * nx) xb_add(&bar[XB_TOPGEN], 1u);
      else XB_SPIN(xb_ld(&bar[XB_TOPGEN]) == tg, bar);
      __builtin_amdgcn_fence(__ATOMIC_ACQUIRE, "agent");
      xb_add(&bar[XB_XGEN(b.x)], 1u);
      asm volatile("s_waitcnt vmcnt(0)" ::: "memory");
    } else {
      XB_SPIN(xb_ld(&bar[XB_XGEN(b.x)]) == gen, bar);
      __builtin_amdgcn_fence(__ATOMIC_ACQUIRE, "agent");
      asm volatile("s_waitcnt vmcnt(0)" ::: "memory");
    }
  }
  __syncthreads();
}

constexpr int LDS_BYTES = GEMM_LDS + 16;

__global__ void __launch_bounds__(NTHREADS) mega_fwd(Params p) {
  extern __shared__ __attribute__((aligned(16))) char smem[];
  cg::grid_group grid = cg::this_grid();
  char* ws = p.ws;
  bf16_t* xn = (bf16_t*)(ws + OFF_XN); bf16_t* proj = (bf16_t*)(ws + OFF_PROJ); bf16_t* ao = (bf16_t*)(ws + OFF_AO);
  LAS unsigned char* shm = (LAS unsigned char*)smem;

  volatile LAS unsigned* bst = (volatile LAS unsigned*)((LAS unsigned char*)smem + GEMM_LDS);
  if (threadIdx.x == 0) { bst[0] = 0u; bst[1] = 0u; }
  __syncthreads();
  const XcdBarrier xbar = xcd_barrier_post((unsigned*)(ws + OFF_BAR), bst);
  convert_weights(p, (float*)smem);

  constexpr int NPH = 8;
  float* ssq_all = (float*)(ws + OFF_SSQ);
#pragma unroll 1
  for (int step = 0; step < NCHUNK * 2 * NPH; ++step) {
    const int ci = step / (2 * NPH), rem = step - ci * (2 * NPH), layer = rem / NPH, ph = rem - layer * NPH;
    const int S = (ci == 0) ? 2048 : 4096, lS = (ci == 0) ? 11 : 12;
    const int TC = (ci == 0) ? 16384 : 32768;
    const float* xin = (ci == 0) ? p.x_prompt : p.x_sample;
    float* h = p.out + (size_t)ci * 16384 * DM;
    float* ssq_c = ssq_all + (size_t)ci * 5 * TCMAX;
    bool did = true;
    switch (ph) {
      case 0:
        if (layer == 0) cast_rows(xin, xn, ssq_c, TC); else did = false;
        break;
      case 1: {
        EpiArgs e; e.outb = proj; e.ldc = (layer == 0) ? EVN : ODN; e.res = nullptr; e.outf = nullptr; e.ssq_in = ssq_c + (size_t)(2 * layer) * TCMAX; e.ssq_out = nullptr;
        gemm_phase<0>(xn, (const bf16_t*)(ws + (layer == 0 ? OFF_WINE : OFF_WINO)), TC, (layer == 0) ? EVN : ODN, DM, shm, e);
      } break;
      case 2:
        if (layer == 1) rope_pass(p, S, TC); else did = false;
        break;
      case 3:
        if (layer == 0) attn_even(p, S, lS, TC, ci, smem); else attn_odd(p, S, lS, TC, smem);
        break;
      case 4:
        if (layer == 1) combine_dil(p, TC); else did = false;
        break;
      case 5: {
        EpiArgs e; e.outb = xn; e.ldc = 0; e.res = xn; e.outf = nullptr; e.ssq_in = nullptr; e.ssq_out = ssq_c + (size_t)(2 * layer + 1) * TCMAX;
        gemm_phase<1>(ao, (const bf16_t*)(ws + (layer == 0 ? OFF_WOUTE : OFF_WOUTO)), TC, DM, DM, shm, e);
      } break;
      case 6: {
        EpiArgs e; e.outb = proj; e.ldc = FF; e.res = nullptr; e.outf = nullptr; e.ssq_in = ssq_c + (size_t)(2 * layer + 1) * TCMAX; e.ssq_out = nullptr;
        gemm_phase<2>(xn, (const bf16_t*)(ws + OFF_WGU + (size_t)layer * SZ_WGU), TC, 2 * FF, DM, shm, e);
      } break;
      default: {
        EpiArgs e; e.outb = xn; e.ldc = 0; e.res = xn; e.outf = nullptr; e.ssq_in = nullptr; e.ssq_out = ssq_c + (size_t)(2 * layer + 2) * TCMAX;
        gemm_phase<1>(proj, (const bf16_t*)(ws + OFF_WD + (size_t)layer * SZ_WD), TC, DM, FF, shm, e);
      } break;
    }
    if (step == 0) grid.sync();
    else if (did) xcd_barrier(xbar);
    if (ph == NPH - 1 && layer == 1) {
      final_norm_rows(xn, p.final_norm_g, h, TC);
      xcd_barrier(xbar);
    }
  }
}

extern "C" void kernel_launch(void* const* d_in, const int* in_sizes, int n_in, void* d_out, int out_size, void* d_ws, size_t ws_size, hipStream_t stream) {
  static int grid_blocks = 0;
  if (!grid_blocks) {
    if (ws_size < WS_END) { fprintf(stderr, "kernel_launch: workspace too small: %zu < %zu\n", ws_size, (size_t)WS_END); return; }
    if (hipFuncSetAttribute((const void*)mega_fwd, hipFuncAttributeMaxDynamicSharedMemorySize, LDS_BYTES) != hipSuccess) { fprintf(stderr, "hipFuncSetAttribute failed\n"); return; }
    int dev = 0, cus = 0, per_cu = 0;
    hipGetDevice(&dev);
    hipDeviceGetAttribute(&cus, hipDeviceAttributeMultiprocessorCount, dev);
    if (hipOccupancyMaxActiveBlocksPerMultiprocessor(&per_cu, (const void*)mega_fwd, NTHREADS, LDS_BYTES) != hipSuccess || per_cu < 1) { fprintf(stderr, "occupancy query failed\n"); return; }
    int g = cus * per_cu; if (g > 256) g = 256; g &= ~7;
    grid_blocks = g;
  }
  Params p{};
  p.x_prompt = (const float*)d_in[0]; p.x_sample = (const float*)d_in[1]; p.attn_norm_g = (const float*)d_in[2]; p.ev_w_in = (const float*)d_in[3];
  p.ev_lambda = (const float*)d_in[4]; p.ev_subln_g = (const float*)d_in[5]; p.ev_rpb = (const float*)d_in[6]; p.ev_w_out = (const float*)d_in[7];
  p.od_w_in = (const float*)d_in[8]; p.od_qk_norm_g = (const float*)d_in[9]; p.od_w_out = (const float*)d_in[10]; p.ffn_norm_g = (const float*)d_in[11];
  p.ffn_w_gate = (const float*)d_in[12]; p.ffn_w_up = (const float*)d_in[13]; p.ffn_w_down = (const float*)d_in[14]; p.final_norm_g = (const float*)d_in[15];
  p.out = (float*)d_out; p.ws = (char*)d_ws;
  if (hipMemsetAsync((char*)d_ws + OFF_BAR, 0, ZERO_BYTES, stream) != hipSuccess) { fprintf(stderr, "memset failed\n"); return; }
  void* args[] = {&p};
  hipError_t e = hipLaunchCooperativeKernel((const void*)mega_fwd, dim3(grid_blocks), dim3(NTHREADS), args, LDS_BYTES, stream);
  if (e != hipSuccess) fprintf(stderr, "cooperative launch failed: %s (grid %d)\n", hipGetErrorString(e), grid_blocks);
}
```
